# Optimizing an MI355X kernel written in HIP

```python
import jax
import jax.numpy as jnp
from jax import lax
import numpy as np

D_MODEL = 2048
BATCH = 4
SEQ = 2048
DEPTH = 4

GRID_W = 64
CTX_LEN = 256
NORM_EPS = 1e-6
N_MOD = 6

GLA_HEADS = 4
GLA_DK = D_MODEL // 2
GLA_DV = D_MODEL
GLA_HDK = GLA_DK // GLA_HEADS
GLA_HDV = GLA_DV // GLA_HEADS
GLA_RANK = 16
GLA_GATE_NORM = 16.0
GLA_CHUNK = 64

ATT_HEADS = 16
ATT_KV_HEADS = 4
ATT_HD = 128
ATT_GROUP = ATT_HEADS // ATT_KV_HEADS
ATT_Q = ATT_HEADS * ATT_HD
ATT_KV = ATT_KV_HEADS * ATT_HD
Q_BLOCK = 128
ROPE_THETA = 10000.0
ROPE_AXIS_PAIRS = ATT_HD // 4

LRU_W = D_MODEL
LRU_BLOCKS = 16
LRU_BS = LRU_W // LRU_BLOCKS
LRU_C = 8.0
CONV_W = 4
CONV_LEFT = 2

N_BRANCH = 3
FFN_HIDDEN = -(-8 * D_MODEL // (3 * 256)) * 256

SPLITS = (GLA_DK, GLA_DK, GLA_DV, GLA_DV, 2 * GLA_RANK, ATT_Q, ATT_KV, ATT_KV, LRU_W, LRU_W, N_BRANCH * D_MODEL)
N_IN = sum(SPLITS)

kernel_name = 'hybrid_gla_gqa_rglru_prefix_dit'


def rmsnorm(x, g):
    xf = x.astype(jnp.float32)
    y = xf * lax.rsqrt(jnp.mean(xf * xf, axis=-1, keepdims=True) + NORM_EPS)
    return (y * g.astype(jnp.float32)).astype(x.dtype)


def modulate(x, shift, scale):
    return x * (1 + scale) + shift


def split_cols(p):
    return jnp.split(p, np.cumsum(SPLITS)[:-1].tolist(), axis=-1)


def flip(z):
    return jnp.flip(z, axis=1)


def axial_rope(n_tokens):
    rows = n_tokens // GRID_W
    row = jnp.repeat(jnp.arange(rows, dtype=jnp.float32), GRID_W)
    col = jnp.tile(jnp.arange(GRID_W, dtype=jnp.float32), rows)
    inv = ROPE_THETA ** (-jnp.arange(ROPE_AXIS_PAIRS, dtype=jnp.float32) / ROPE_AXIS_PAIRS)
    ang = jnp.concatenate([row[:, None] * inv, col[:, None] * inv], axis=-1)
    return jnp.cos(ang), jnp.sin(ang)


def apply_rope(x, cos, sin):
    c_ = cos[None, :, None, :].astype(x.dtype)
    s_ = sin[None, :, None, :].astype(x.dtype)
    x1, x2 = x[..., 0::2], x[..., 1::2]
    return jnp.stack([x1 * c_ - x2 * s_, x1 * s_ + x2 * c_], axis=-1).reshape(x.shape)


def gla_scan(q, k, v, log_a, s0):
    B, T, H, _ = q.shape
    n = T // GLA_CHUNK

    def chunks(z):
        return z.astype(jnp.float32).reshape(B, n, GLA_CHUNK, H, z.shape[-1]).transpose(1, 0, 3, 2, 4)

    qc, kc, vc, gc = chunks(q), chunks(k), chunks(v), chunks(log_a)
    b = jnp.cumsum(gc, axis=3)
    b_last = b[:, :, :, -1:, :]
    q_dec = qc * jnp.exp(b)
    k_dec = kc * jnp.exp(b_last - b)
    lower = jnp.tril(jnp.ones((GLA_CHUNK, GLA_CHUNK), dtype=bool))
    att = jnp.einsum('nbhid,nbhjd->nbhij', q_dec, kc * jnp.exp(-b))
    att = jnp.where(lower, att, 0.0)
    o_intra = jnp.einsum('nbhij,nbhjv->nbhiv', att, vc)

    def step(s, xs):
        qd, kd, vv, dl = xs
        o = jnp.einsum('bhid,bhdv->bhiv', qd, s)
        s = s * dl[:, :, 0, :, None] + jnp.einsum('bhjd,bhjv->bhdv', kd, vv)
        return s, o

    s_fin, o_inter = lax.scan(step, s0, (q_dec, k_dec, vc, jnp.exp(b_last)))
    o = (o_intra + o_inter).transpose(1, 0, 3, 2, 4).reshape(B, T, H, v.shape[-1])
    return o.astype(v.dtype), s_fin


def gla_prep(q, k, v, dec, w_decay, b_decay):
    B, T, _ = q.shape
    la = jax.nn.log_sigmoid(
        jnp.einsum('btnr,nrk->btnk', dec.reshape(B, T, 2, GLA_RANK).astype(jnp.float32), w_decay.astype(jnp.float32))
        + b_decay.astype(jnp.float32)) / GLA_GATE_NORM
    la = la.reshape(B, T, 2, GLA_HEADS, GLA_HDK)
    qh = q.reshape(B, T, GLA_HEADS, GLA_HDK) * (GLA_HDK ** -0.5)
    kh = k.reshape(B, T, GLA_HEADS, GLA_HDK)
    vh = v.reshape(B, T, GLA_HEADS, GLA_HDV)
    return qh, kh, vh, la[:, :, 0], la[:, :, 1]


def gla_out(o, r, norm_g):
    B, T = o.shape[:2]
    return rmsnorm(o, norm_g).reshape(B, T, GLA_DV).astype(r.dtype) * jax.nn.silu(r)


def gla_branch(q, k, v, r, dec, cq, ck, cv, cr, cdec, w_decay, b_decay, norm_g, need_ctx):
    qh, kh, vh, lf, lb = gla_prep(q, k, v, dec, w_decay, b_decay)
    cqh, ckh, cvh, clf, clb = gla_prep(cq, ck, cv, cdec, w_decay, b_decay)
    B = q.shape[0]
    s0 = jnp.zeros((B, GLA_HEADS, GLA_HDK, GLA_HDV), jnp.float32)
    oc_f, s_f = gla_scan(cqh, ckh, cvh, clf, s0)
    oc_b, s_b = gla_scan(flip(cqh), flip(ckh), flip(cvh), flip(clb), s0)
    o_f, _ = gla_scan(qh, kh, vh, lf, s_f)
    o_b, _ = gla_scan(flip(qh), flip(kh), flip(vh), flip(lb), s_b)
    out = gla_out(o_f + flip(o_b), r, norm_g)
    out_c = gla_out(oc_f + flip(oc_b), cr, norm_g) if need_ctx else None
    return out, out_c


def gqa_attend(q, k, v):
    s = jnp.einsum('bqkgd,bskd->bkgqs', q.astype(jnp.float32), k.astype(jnp.float32)) * (ATT_HD ** -0.5)
    p = jax.nn.softmax(s, axis=-1)
    return jnp.einsum('bkgqs,bskd->bqkgd', p.astype(v.dtype), v)


def gqa_branch(q, k, v, cq, ck, cv, q_g, k_g, cos, sin, need_ctx):
    B, T, _ = q.shape
    Lc = cq.shape[1]

    def heads(z, n):
        return z.reshape(z.shape[0], z.shape[1], n, ATT_HD)

    qh = apply_rope(rmsnorm(heads(q, ATT_HEADS), q_g), cos, sin)
    kh = apply_rope(rmsnorm(heads(k, ATT_KV_HEADS), k_g), cos, sin)
    vh = heads(v, ATT_KV_HEADS)
    cqh = rmsnorm(heads(cq, ATT_HEADS), q_g)
    ckh = rmsnorm(heads(ck, ATT_KV_HEADS), k_g)
    cvh = heads(cv, ATT_KV_HEADS)
    k_all = jnp.concatenate([kh, ckh], axis=1)
    v_all = jnp.concatenate([vh, cvh], axis=1)
    nb = T // Q_BLOCK
    qb = qh.reshape(B, nb, Q_BLOCK, ATT_KV_HEADS, ATT_GROUP, ATT_HD).transpose(1, 0, 2, 3, 4, 5)
    o = lax.map(lambda blk: gqa_attend(blk, k_all, v_all), qb)
    out = o.transpose(1, 0, 2, 3, 4, 5).reshape(B, T, ATT_Q)
    out_c = None
    if need_ctx:
        out_c = gqa_attend(cqh.reshape(B, Lc, ATT_KV_HEADS, ATT_GROUP, ATT_HD), ckh, cvh).reshape(B, Lc, ATT_Q)
    return out, out_c


def dwconv_centred(x, w, b):
    T = x.shape[1]
    xp = jnp.pad(x, ((0, 0), (CONV_LEFT, CONV_W - 1 - CONV_LEFT), (0, 0)))
    out = b
    for j in range(CONV_W):
        out = out + xp[:, j:j + T] * w[j]
    return out


def _lin_combine(left, right):
    a_l, b_l = left
    a_r, b_r = right
    return a_l * a_r, a_r * b_l + b_r


def rglru_scan(x, w_a, b_a, w_i, b_i, lam, h0, reset_first):
    B, T, W = x.shape
    xf = x.astype(jnp.float32)
    xb = xf.reshape(B, T, LRU_BLOCKS, LRU_BS)
    r = jax.nn.sigmoid(jnp.einsum('btnk,nkj->btnj', xb, w_a.astype(jnp.float32)).reshape(B, T, W) + b_a)
    i = jax.nn.sigmoid(jnp.einsum('btnk,nkj->btnj', xb, w_i.astype(jnp.float32)).reshape(B, T, W) + b_i)
    log_a = -LRU_C * r * jax.nn.softplus(-lam.astype(jnp.float32))
    a = jnp.exp(log_a)
    mult = jnp.sqrt(-jnp.expm1(2.0 * log_a))
    if reset_first:
        mult = mult.at[:, 0].set(1.0)
    a_cum, h = lax.associative_scan(_lin_combine, (a, mult * i * xf), axis=1)
    h = h + a_cum * h0[:, None]
    return h.astype(x.dtype), h[:, -1]


def lru_branch(x_lat, y_lat, x_ctx, y_ctx, conv_w, conv_b, w_a, b_a, w_i, b_i, lam, need_ctx):
    xl = dwconv_centred(x_lat, conv_w, conv_b)
    xc = dwconv_centred(x_ctx, conv_w, conv_b)
    h0 = jnp.zeros((x_lat.shape[0], LRU_W), jnp.float32)
    hc_f, s_f = rglru_scan(xc, w_a[0], b_a[0], w_i[0], b_i[0], lam[0], h0, True)
    hc_b, s_b = rglru_scan(flip(xc), w_a[1], b_a[1], w_i[1], b_i[1], lam[1], h0, True)
    hl_f, _ = rglru_scan(xl, w_a[0], b_a[0], w_i[0], b_i[0], lam[0], s_f, False)
    hl_b, _ = rglru_scan(flip(xl), w_a[1], b_a[1], w_i[1], b_i[1], lam[1], s_b, False)
    out = (hl_f + flip(hl_b)) * jax.nn.gelu(y_lat)
    out_c = (hc_f + flip(hc_b)) * jax.nn.gelu(y_ctx) if need_ctx else None
    return out, out_c


def merge_project(o_a, o_b, o_c, gate_logits, b_merge, w_branch, w_out):
    B, T, _ = o_a.shape
    gates = jax.nn.sigmoid(gate_logits.reshape(B, T, N_BRANCH, D_MODEL).astype(jnp.float32) + b_merge)
    proj = jnp.einsum('btnw,nwd->btnd', jnp.stack([o_a, o_b, o_c], axis=2), w_branch)
    merged = jnp.einsum('btnd,btnd->btd', gates.astype(proj.dtype), proj)
    return merged @ w_out


def hybrid_mixer(u, uc, w_in, gla_w_decay, gla_b_decay, gla_norm_g, q_norm_g, k_norm_g,
                 conv_w, conv_b, lru_w_a, lru_b_a, lru_w_i, lru_b_i, lru_lambda,
                 b_merge, w_branch, w_out, cos, sin, need_ctx):
    g_q, g_k, g_v, g_r, g_dec, a_q, a_k, a_v, l_x, l_y, gates = split_cols(u @ w_in)
    cg_q, cg_k, cg_v, cg_r, cg_dec, ca_q, ca_k, ca_v, cl_x, cl_y, cgates = split_cols(uc @ w_in)
    o_gla, oc_gla = gla_branch(g_q, g_k, g_v, g_r, g_dec, cg_q, cg_k, cg_v, cg_r, cg_dec,
                               gla_w_decay, gla_b_decay, gla_norm_g, need_ctx)
    o_att, oc_att = gqa_branch(a_q, a_k, a_v, ca_q, ca_k, ca_v, q_norm_g, k_norm_g, cos, sin, need_ctx)
    o_lru, oc_lru = lru_branch(l_x, l_y, cl_x, cl_y, conv_w, conv_b, lru_w_a, lru_b_a,
                               lru_w_i, lru_b_i, lru_lambda, need_ctx)
    y = merge_project(o_gla, o_att, o_lru, gates, b_merge, w_branch, w_out)
    yc = merge_project(oc_gla, oc_att, oc_lru, cgates, b_merge, w_branch, w_out) if need_ctx else None
    return y, yc


def swiglu(u, w_in, w_out):
    g, up = jnp.split(u @ w_in, 2, axis=-1)
    return (jax.nn.silu(g) * up) @ w_out


def setup_inputs(seed: int = 0) -> dict:
    key = jax.random.key(seed)
    ks = iter(jax.random.split(key, 32))
    f32 = jnp.float32
    D = D_MODEL

    def nrm(shape, scale):
        return jax.random.normal(next(ks), shape, f32) * scale

    u = jax.random.uniform(next(ks), (DEPTH, 2, LRU_W), f32, 0.9, 0.999)
    p = u ** (1.0 / LRU_C)
    return {
        'x': nrm((BATCH, SEQ, D), 1.0),
        'c': nrm((BATCH, D), 1.0),
        'ctx': nrm((BATCH, CTX_LEN, D), 1.0),
        'c_ctx': nrm((D,), 1.0),
        'w_mod': nrm((DEPTH, D, N_MOD * D), 0.5 * D ** -0.5),
        'b_mod': nrm((DEPTH, N_MOD * D), 0.02),
        'norm_mix_g': 1.0 + nrm((DEPTH, D), 0.02),
        'norm_ffn_g': 1.0 + nrm((DEPTH, D), 0.02),
        'w_in': nrm((DEPTH, D, N_IN), D ** -0.5),
        'gla_w_decay': nrm((DEPTH, 2, GLA_RANK, GLA_DK), GLA_RANK ** -0.5),
        'gla_b_decay': nrm((DEPTH, 2, GLA_DK), 0.5),
        'gla_norm_g': 1.0 + nrm((DEPTH, GLA_HDV), 0.02),
        'q_norm_g': 1.0 + nrm((DEPTH, ATT_HD), 0.02),
        'k_norm_g': 1.0 + nrm((DEPTH, ATT_HD), 0.02),
        'conv_w': nrm((DEPTH, CONV_W, LRU_W), CONV_W ** -0.5),
        'conv_b': nrm((DEPTH, LRU_W), 0.02),
        'lru_w_a': nrm((DEPTH, 2, LRU_BLOCKS, LRU_BS, LRU_BS), LRU_BS ** -0.5),
        'lru_b_a': nrm((DEPTH, 2, LRU_W), 0.02),
        'lru_w_i': nrm((DEPTH, 2, LRU_BLOCKS, LRU_BS, LRU_BS), LRU_BS ** -0.5),
        'lru_b_i': nrm((DEPTH, 2, LRU_W), 0.02),
        'lru_lambda': jnp.log(p) - jnp.log1p(-p),
        'b_merge': nrm((DEPTH, N_BRANCH, D), 0.02),
        'w_branch': nrm((DEPTH, N_BRANCH, GLA_DV, D), GLA_DV ** -0.5),
        'w_out': nrm((DEPTH, D, D), D ** -0.5),
        'w_ffn_in': nrm((DEPTH, D, 2 * FFN_HIDDEN), D ** -0.5),
        'w_ffn_out': nrm((DEPTH, FFN_HIDDEN, D), FFN_HIDDEN ** -0.5),
        'final_norm_g': 1.0 + nrm((D,), 0.02),
    }


def reference(x, c, ctx, c_ctx, w_mod, b_mod, norm_mix_g, norm_ffn_g, w_in, gla_w_decay, gla_b_decay,
              gla_norm_g, q_norm_g, k_norm_g, conv_w, conv_b, lru_w_a, lru_b_a, lru_w_i, lru_b_i,
              lru_lambda, b_merge, w_branch, w_out, w_ffn_in, w_ffn_out, final_norm_g):
    T = x.shape[1]
    cos, sin = axial_rope(T)
    sc = jax.nn.silu(c)
    scc = jax.nn.silu(c_ctx)
    h, hc = x, ctx
    for l in range(DEPTH):
        need_ctx = l < DEPTH - 1
        m = sc @ w_mod[l] + b_mod[l]
        mc = scc @ w_mod[l] + b_mod[l]
        sh1, s1, g1, sh2, s2, g2 = [z[:, None] for z in jnp.split(m, N_MOD, axis=-1)]
        csh1, cs1, cg1, csh2, cs2, cg2 = jnp.split(mc, N_MOD, axis=-1)
        u = modulate(rmsnorm(h, norm_mix_g[l]), sh1, s1)
        uc = modulate(rmsnorm(hc, norm_mix_g[l]), csh1, cs1)
        y, yc = hybrid_mixer(u, uc, w_in[l], gla_w_decay[l], gla_b_decay[l], gla_norm_g[l],
                             q_norm_g[l], k_norm_g[l], conv_w[l], conv_b[l], lru_w_a[l], lru_b_a[l],
                             lru_w_i[l], lru_b_i[l], lru_lambda[l], b_merge[l], w_branch[l], w_out[l],
                             cos, sin, need_ctx)
        h = h + g1 * y
        h = h + g2 * swiglu(modulate(rmsnorm(h, norm_ffn_g[l]), sh2, s2), w_ffn_in[l], w_ffn_out[l])
        if need_ctx:
            hc = hc + cg1 * yc
            hc = hc + cg2 * swiglu(modulate(rmsnorm(hc, norm_ffn_g[l]), csh2, cs2), w_ffn_in[l], w_ffn_out[l])
    return rmsnorm(h, final_norm_g)
```

```cpp
#include <hip/hip_runtime.h>
#include <hip/hip_bf16.h>
#include <cstdio>
#include <cstdint>
#define LAS __attribute__((address_space(3)))
#define GAS __attribute__((address_space(1)))
namespace pg8 {
#define PG8_LAS __attribute__((address_space(3)))
typedef unsigned short bf16_t;
typedef short bf16x8 __attribute__((ext_vector_type(8)));
typedef float f32x4 __attribute__((ext_vector_type(4)));
typedef unsigned u32x4 __attribute__((ext_vector_type(4)));
constexpr int BM = 256, BK = 64, HALF = 128, HTB = HALF * BK * 2  , STAGE_BYTES = 8 * HTB, NXCD = 8, WGM = 8;

__host__ __device__ __forceinline__ int lds_byte(int r, int c) { const int st = (r >> 4) * 2 + (c >> 5), rr = r & 15, cc = c & 31, ob = rr * 64 + cc * 2; return st * 1024 + (ob ^ (((ob >> 9) & 1) << 5)); }
__host__ __device__ __forceinline__ void stage_rc(int b, int& R, int& C) { const int st = b / 1024, sb = b % 1024, swz = sb ^ (((sb >> 9) & 1) << 5); R = (st >> 1) * 16 + swz / 64; C = (st & 1) * 32 + (swz % 64) / 2; }
__host__ __device__ __forceinline__ int perm32(int rho) { const int n = rho >> 4, i = rho & 15; return 8 * (i >> 2) + 4 * n + (i & 3); }

struct Unit { int pm, pn; };
struct Gemm { const bf16_t* A; const bf16_t* Bt; int M, N, K; };

struct StaticOrder {
    int nM, nN, nwg, G, c;
    __host__ __device__ void init(int M, int N, int G_, int c_) { nM = M / BM; nN = N / BM; nwg = nM * nN; G = G_; c = c_; }
    __host__ __device__ bool next(int i, Unit& u) const {
        const long L = (long)i * G + c; if (L >= nwg) return false;
        int wgid = (int)L; { const int q = nwg / NXCD, r = nwg % NXCD, xcd = wgid % NXCD, off = wgid / NXCD; wgid = (xcd < r ? xcd * (q + 1) : r * (q + 1) + (xcd - r) * q) + off; }
        const int nig = WGM * nN, gid = wgid / nig, fm = gid * WGM, gsz = (nM - fm) < WGM ? (nM - fm) : WGM;
        u.pm = fm + ((wgid % nig) % gsz); u.pn = (wgid % nig) / gsz; return true;
    }
    __device__ __forceinline__ void a_ready(const Unit&) const {}
    __device__ __forceinline__ void done(const Unit&) const {}
};

__device__ __forceinline__ unsigned cvt_pk_bf16(float lo, float hi) { unsigned r; asm volatile("v_cvt_pk_bf16_f32 %0, %1, %2" : "=v"(r) : "v"(lo), "v"(hi)); return r; }
template <class Epi, class Sched, bool ALIGN_EPI = false, bool SP2 = false>
__device__ __forceinline__ void gemm_phase(PG8_LAS unsigned char* lds, const Gemm g, const Sched& S, const Epi& E) {
    int tid_ = threadIdx.x; asm volatile("" : "+v"(tid_));
    const int tid = tid_, wid = __builtin_amdgcn_readfirstlane(tid >> 6), lane = tid & 63, wr = wid >> 2, wc = wid & 3, fr = lane & 15, fq = lane >> 4;
    const int K = g.K, nt = K / BK;
    unsigned voffA[2], voffB[2];
#pragma unroll
    for (int i = 0; i < 2; ++i) { int R, C; stage_rc(tid * 16 + i * 8192, R, C); const int Rb = Epi::PERM ? ((R & ~31) + perm32(R & 31)) : R;
        voffA[i] = (unsigned)(R * K + C) * 2u; voffB[i] = (unsigned)(Rb * K + C) * 2u; }
    const size_t kstep = (size_t)(BK * 2);
    const size_t hstep = (size_t)HALF * K * 2;
    const size_t tstep = 2 * hstep;
    const unsigned ldsw = (unsigned)wid * 1024u;
    const int aoff = lds_byte(wr * 64 + fr, fq * 8), boff = lds_byte(wc * 32 + fr, fq * 8);
#define PG8_SA(b, h) (((b) * 2 + (h)) * HTB)
#define PG8_SB(b, h) ((4 + (b) * 2 + (h)) * HTB)
#define PG8_STAGE(bufoff, gbase, voff) do { _Pragma("unroll") for (int _i = 0; _i < 2; ++_i) \
        __builtin_amdgcn_global_load_lds((const unsigned*)((const char*)(gbase) + (voff)[_i]), (PG8_LAS unsigned*)(lds + (bufoff) + ldsw + _i * 8192), 16, 0, 0); } while (0)
#define PG8_LDA(dst, b, h) do { _Pragma("unroll") for (int m = 0; m < 4; ++m) _Pragma("unroll") for (int k = 0; k < 2; ++k) dst[m][k] = *(const PG8_LAS bf16x8*)(lds + PG8_SA(b, h) + aoff + m * 2048 + k * 1024); } while (0)
#define PG8_LDB(dst, b, h) do { _Pragma("unroll") for (int n = 0; n < 2; ++n) _Pragma("unroll") for (int k = 0; k < 2; ++k) dst[n][k] = *(const PG8_LAS bf16x8*)(lds + PG8_SB(b, h) + boff + n * 2048 + k * 1024); } while (0)
#define PG8_MMA(ai, bj, At, Bt) do { __builtin_amdgcn_s_setprio(1); _Pragma("unroll") for (int m = 0; m < 4; ++m) _Pragma("unroll") for (int n = 0; n < 2; ++n) _Pragma("unroll") for (int k = 0; k < 2; ++k) \
        acc[ai][bj][m][n] = __builtin_amdgcn_mfma_f32_16x16x32_bf16(Bt[n][k], At[m][k], acc[ai][bj][m][n], 0, 0, 0); __builtin_amdgcn_s_setprio(0); } while (0)
#define PG8_WAIT_V(n) asm volatile("s_waitcnt vmcnt(" #n ")" ::: "memory")
#define PG8_WAIT_L(n) asm volatile("s_waitcnt lgkmcnt(" #n ")" ::: "memory")
#define PG8_BAR __builtin_amdgcn_s_barrier()
#define PG8_SCHED __builtin_amdgcn_sched_barrier(0)
    Unit cur, nxt; int ui = 0;
    if (!S.next(0, cur)) return;
    f32x4 acc[2][2][4][2];
#pragma unroll
    for (int a = 0; a < 2; ++a)
#pragma unroll
        for (int b = 0; b < 2; ++b)
#pragma unroll
            for (int m = 0; m < 4; ++m)
#pragma unroll
                for (int n = 0; n < 2; ++n) acc[a][b][m][n] = (f32x4){0.f, 0.f, 0.f, 0.f};
    bf16x8 At[4][2], B0[2][2], B1[2][2];
    const char* cA = (const char*)g.A + (size_t)cur.pm * tstep; const char* cB = (const char*)g.Bt + (size_t)cur.pn * tstep;
    S.a_ready(cur);
    if constexpr (SP2) {
        PG8_STAGE(PG8_SB(0, 0), cB, voffB); PG8_STAGE(PG8_SB(0, 1), cB + hstep, voffB); PG8_STAGE(PG8_SA(0, 0), cA, voffA); PG8_STAGE(PG8_SA(0, 1), cA + hstep, voffA);
        if (wr == 1) PG8_BAR;
        PG8_WAIT_V(2); PG8_BAR;
        PG8_STAGE(PG8_SB(1, 0), cB + kstep, voffB); PG8_STAGE(PG8_SA(1, 0), cA + kstep, voffA); PG8_STAGE(PG8_SB(1, 1), cB + hstep + kstep, voffB);
        PG8_WAIT_V(6); PG8_BAR;
    } else {
        PG8_STAGE(PG8_SB(0, 0), cB, voffB); PG8_STAGE(PG8_SA(0, 0), cA, voffA); PG8_STAGE(PG8_SB(0, 1), cB + hstep, voffB); PG8_STAGE(PG8_SA(0, 1), cA + hstep, voffA);
        if (wr == 1) PG8_BAR;
        PG8_WAIT_V(4); PG8_BAR;
        PG8_STAGE(PG8_SB(1, 0), cB + kstep, voffB); PG8_STAGE(PG8_SA(1, 0), cA + kstep, voffA); PG8_STAGE(PG8_SB(1, 1), cB + hstep + kstep, voffB);
        PG8_WAIT_V(6); PG8_BAR;
    }
    for (;;) {
        const bool has_next = S.next(ui + 1, nxt);
        const char* nA = has_next ? (const char*)g.A + (size_t)nxt.pm * tstep : cA; const char* nB = has_next ? (const char*)g.Bt + (size_t)nxt.pn * tstep : cB;
        for (int t = 0; t < nt; t += 2) {
            const bool last = (t == nt - 2);
            const char* a1 = cA + (size_t)(t + 1) * kstep;
            const char* a2 = last ? nA : cA + (size_t)(t + 2) * kstep; const char* b2 = last ? nB : cB + (size_t)(t + 2) * kstep;
            const char* a3 = a2 + kstep; const char* b3 = b2 + kstep;
            if (last && has_next) S.a_ready(nxt);
            if constexpr (SP2) {
            PG8_LDB(B0, 0, 0); PG8_LDB(B1, 0, 1); PG8_SCHED; PG8_LDA(At, 0, 0); PG8_STAGE(PG8_SA(1, 1), a1 + hstep, voffA);
            PG8_WAIT_V(8); PG8_WAIT_L(0); PG8_BAR; PG8_MMA(0, 0, At, B0); PG8_MMA(0, 1, At, B1); PG8_BAR; PG8_SCHED;
            PG8_LDA(At, 0, 1); PG8_STAGE(PG8_SB(0, 0), b2, voffB); PG8_STAGE(PG8_SB(0, 1), b2 + hstep, voffB); PG8_STAGE(PG8_SA(0, 0), a2, voffA);
            PG8_WAIT_V(8); PG8_WAIT_L(0); PG8_BAR; PG8_MMA(1, 0, At, B0); PG8_MMA(1, 1, At, B1); PG8_BAR; PG8_SCHED;
            PG8_LDB(B0, 1, 0); PG8_LDB(B1, 1, 1); PG8_SCHED; PG8_LDA(At, 1, 0); PG8_STAGE(PG8_SA(0, 1), a2 + hstep, voffA);
            PG8_WAIT_V(8); PG8_WAIT_L(0); PG8_BAR; PG8_MMA(0, 0, At, B0); PG8_MMA(0, 1, At, B1); PG8_BAR; PG8_SCHED;
            PG8_LDA(At, 1, 1); PG8_STAGE(PG8_SB(1, 0), b3, voffB); PG8_STAGE(PG8_SB(1, 1), b3 + hstep, voffB); PG8_STAGE(PG8_SA(1, 0), a3, voffA);
            PG8_WAIT_V(8); PG8_WAIT_L(0); PG8_BAR; PG8_MMA(1, 0, At, B0); PG8_MMA(1, 1, At, B1); PG8_BAR; PG8_SCHED;
            } else {
            PG8_LDB(B0, 0, 0); PG8_SCHED; PG8_LDA(At, 0, 0); PG8_STAGE(PG8_SA(1, 1), a1 + hstep, voffA);
            PG8_WAIT_L(8); PG8_BAR; PG8_WAIT_L(0); PG8_MMA(0, 0, At, B0); PG8_BAR; PG8_SCHED;
            PG8_LDB(B1, 0, 1); PG8_STAGE(PG8_SB(0, 0), b2, voffB);
            PG8_BAR; PG8_WAIT_L(0); PG8_MMA(0, 1, At, B1); PG8_BAR;
            PG8_LDA(At, 0, 1); PG8_STAGE(PG8_SA(0, 0), a2, voffA);
            PG8_BAR; PG8_WAIT_L(0); PG8_MMA(1, 0, At, B0); PG8_BAR; PG8_SCHED;
            PG8_STAGE(PG8_SB(0, 1), b2 + hstep, voffB);
            PG8_WAIT_V(6); PG8_BAR; PG8_MMA(1, 1, At, B1); PG8_BAR;
            PG8_LDB(B0, 1, 0); PG8_SCHED; PG8_LDA(At, 1, 0); PG8_STAGE(PG8_SA(0, 1), a2 + hstep, voffA);
            PG8_WAIT_L(8); PG8_BAR; PG8_WAIT_L(0); PG8_MMA(0, 0, At, B0); PG8_BAR; PG8_SCHED;
            PG8_LDB(B1, 1, 1); PG8_STAGE(PG8_SB(1, 0), b3, voffB);
            PG8_BAR; PG8_WAIT_L(0); PG8_MMA(0, 1, At, B1); PG8_BAR;
            PG8_LDA(At, 1, 1); PG8_STAGE(PG8_SA(1, 0), a3, voffA);
            PG8_BAR; PG8_WAIT_L(0); PG8_MMA(1, 0, At, B0); PG8_BAR; PG8_SCHED;
            PG8_STAGE(PG8_SB(1, 1), b3 + hstep, voffB);
            PG8_WAIT_V(6); PG8_BAR; PG8_MMA(1, 1, At, B1); PG8_BAR;
            }
        }
        if constexpr (ALIGN_EPI) { if (wr == 0) PG8_BAR; }
        if constexpr (!Epi::AFTER_DRAIN) { E(acc, cur, wr, wc, fr, fq); S.done(cur); }
        if (!has_next) break;
#pragma unroll
        for (int a = 0; a < 2; ++a)
#pragma unroll
            for (int b = 0; b < 2; ++b)
#pragma unroll
                for (int m = 0; m < 4; ++m)
#pragma unroll
                    for (int n = 0; n < 2; ++n) acc[a][b][m][n] = (f32x4){0.f, 0.f, 0.f, 0.f};
        cur = nxt; cA = nA; cB = nB; ++ui;
        if constexpr (ALIGN_EPI) { if (wr == 1) PG8_BAR; }
    }
    PG8_WAIT_V(0);
    if constexpr (!ALIGN_EPI) { if (wr == 0) PG8_BAR; }
    PG8_BAR;
    if constexpr (Epi::AFTER_DRAIN) { E.fused(acc, cur, wr, wc, fr, fq, lds, wid, lane); S.done(cur); }
#undef PG8_SA
#undef PG8_SB
#undef PG8_STAGE
#undef PG8_LDA
#undef PG8_LDB
#undef PG8_MMA
#undef PG8_WAIT_V
#undef PG8_WAIT_L
#undef PG8_BAR
#undef PG8_SCHED
}
}
#define XB_TMO      128
#define XB_XCNT(j)  (256  + 64 * (j))
#define XB_XSUB(j)  (1280 + 64 * (j))
#define XB_XGEN(j)  (2304 + 64 * (j))
#define XB_TOP      3328
#define XB_TOPGEN   3392
#define XCD_BAR_WORDS 3456
#define XB_SPIN_CAP (1u << 18)

__device__ __forceinline__ unsigned xb_ld(unsigned* p)              { return __hip_atomic_load(p, __ATOMIC_RELAXED, __HIP_MEMORY_SCOPE_AGENT); }
__device__ __forceinline__ unsigned xb_add(unsigned* p, unsigned v) { return __hip_atomic_fetch_add(p, v, __ATOMIC_RELAXED, __HIP_MEMORY_SCOPE_AGENT); }
__device__ __forceinline__ unsigned xb_xcc_id() { return (unsigned)__builtin_amdgcn_s_getreg((3 << 11) | 20) & 0xFu; }
#define XB_SPIN(cond, bar) do { unsigned _sp = 0; while (cond) { __builtin_amdgcn_s_sleep(1); \
    if ((++_sp & 255u) == 0u) { if (xb_ld(&(bar)[XB_TMO])) break; if (_sp > XB_SPIN_CAP) { atomicAdd(&(bar)[XB_TMO], 1u); break; } } } } while (0)

struct XcdBarrier {
    unsigned* bar; unsigned x;
    volatile LAS unsigned* st;
};

__device__ __forceinline__ XcdBarrier xcd_barrier_post(unsigned* bar, volatile LAS unsigned* st) {
    XcdBarrier b; b.bar = bar; b.x = xb_xcc_id(); b.st = st;
    if (threadIdx.x == 0) (void)xb_add(&bar[XB_XCNT(b.x)], 1u);
    return b;
}
__device__ __forceinline__ void xcd_barrier_complete(unsigned* bar, unsigned x, unsigned& nloc, unsigned& nx) {
    const unsigned G = gridDim.x * gridDim.y * gridDim.z;
    unsigned sum, cnt, mine, sp = 0u;
    for (;;) {
        sum = 0u; cnt = 0u; mine = 0u;
#pragma unroll
        for (unsigned j = 0; j < 16; ++j) { const unsigned c = xb_ld(&bar[XB_XCNT(j)]); sum += c; cnt += (c > 0u) ? 1u : 0u; mine = (j == x) ? c : mine; }
        if (sum == G) break;
        __builtin_amdgcn_s_sleep(1);
        if ((++sp & 255u) == 0u) { if (xb_ld(&bar[XB_TMO])) break; if (sp > XB_SPIN_CAP) { atomicAdd(&bar[XB_TMO], 1u); break; } }
    }
    nloc = mine > 0u ? mine : 1u; nx = cnt > 0u ? cnt : 1u;
}

__device__ __forceinline__ void xcd_barrier(const XcdBarrier& b) {
    asm volatile("s_waitcnt vmcnt(0)" ::: "memory");
    __syncthreads();
    if (threadIdx.x == 0) {
        unsigned* bar = b.bar;
        __builtin_amdgcn_s_waitcnt(0);
        unsigned nloc = b.st[0], nx = b.st[1];
        if (nloc == 0u) { xcd_barrier_complete(bar, b.x, nloc, nx); b.st[0] = nloc; b.st[1] = nx; }
        const unsigned old = xb_add(&bar[XB_XSUB(b.x)], 1u);
        const unsigned gen = old / nloc;
        if (old + 1u == (gen + 1u) * nloc) {
            __builtin_amdgcn_fence(__ATOMIC_RELEASE, "agent");
            asm volatile("s_waitcnt vmcnt(0)" ::: "memory");
            const unsigned og = xb_add(&bar[XB_TOP], 1u);
            const unsigned tg = og / nx;
            if (og + 1u == (tg + 1u) * nx) xb_add(&bar[XB_TOPGEN], 1u);
            else XB_SPIN(xb_ld(&bar[XB_TOPGEN]) == tg, bar);
            __builtin_amdgcn_fence(__ATOMIC_ACQUIRE, "agent");
            xb_add(&bar[XB_XGEN(b.x)], 1u);
            asm volatile("s_waitcnt vmcnt(0)" ::: "memory");
        } else {
            XB_SPIN(xb_ld(&bar[XB_XGEN(b.x)]) == gen, bar);
            __builtin_amdgcn_fence(__ATOMIC_ACQUIRE, "agent");
            asm volatile("s_waitcnt vmcnt(0)" ::: "memory");
        }
    }
    __syncthreads();
}
#ifndef PH_MASK
#define PH_MASK 0xFFFFFFFFu
#endif
#define EN(k) (((PH_MASK) >> (k)) & 1u)
namespace mk {
typedef unsigned short bf16;
typedef short bf16x8 __attribute__((ext_vector_type(8)));
typedef short s16x4 __attribute__((ext_vector_type(4)));
typedef float f32x2 __attribute__((ext_vector_type(2)));
typedef float f32x4 __attribute__((ext_vector_type(4)));
typedef float f32x16 __attribute__((ext_vector_type(16)));
typedef unsigned u32x2 __attribute__((ext_vector_type(2)));
typedef unsigned u32x4 __attribute__((ext_vector_type(4)));

constexpr int D = 2048, NB = 4, TL = 2048, LC = 256, TT = 2304, M = NB * TT, DEPTH = 4;
constexpr int NIN = 19488, NP = 19456, NINP = 19712, FF = 5632, NF1 = 11264;
constexpr int C_GQ = 0, C_GK = 1024, C_GV = 2048, C_GR = 4096, C_AQ = 6144, C_AK = 8192, C_AV = 8704, C_LX = 9216, C_LY = 11264, C_GATE = 13312;
constexpr float EPS = 1e-6f;
constexpr int NWAVES = 8, NTHR = 512;

enum { I_X = 0, I_C, I_CTX, I_CCTX, I_WMOD, I_BMOD, I_NMIX, I_NFFN, I_WIN, I_GWD, I_GBD, I_GNG, I_QNG, I_KNG, I_CW, I_CB, I_LWA, I_LBA, I_LWI, I_LBI, I_LAM, I_BMERGE, I_WBR, I_WOUT,
       I_WF1, I_WF2, I_FNG, N_INPUTS };

constexpr size_t MiB = 1u << 20;
constexpr size_t WS_CTL = 0, CTL_ZERO_BYTES = 1 * MiB;
constexpr size_t WS_MOD = 1 * MiB, WS_ROPE = 2 * MiB, WS_DEC = 4 * MiB, WS_DL = 6 * MiB, WS_WL = 8 * MiB;
constexpr size_t WS_WIN = 16 * MiB, WIN_L = 77 * MiB;
constexpr size_t WS_WBR = 324 * MiB, WBR_L = 24 * MiB;
constexpr size_t WS_WOUT = 420 * MiB, WOUT_L = 8 * MiB;
constexpr size_t WS_WF1 = 452 * MiB, WF1_L = 44 * MiB;
constexpr size_t WS_WF2 = 628 * MiB, WF2_L = 22 * MiB;
constexpr size_t WS_H = 716 * MiB, WS_U = 788 * MiB, WS_PROJ = 824 * MiB;
constexpr size_t WS_QD = 1166 * MiB, QD_ONE = 18 * MiB;
constexpr size_t WS_OF = 1274 * MiB, WS_OB = 1310 * MiB;
constexpr size_t WS_LA = 1346 * MiB, ACT36 = 36 * MiB;
constexpr size_t WS_HS = 1490 * MiB;
constexpr size_t WS_OBR = 1562 * MiB;
constexpr size_t WS_MF = 1670 * MiB, WS_MG = 1742 * MiB, WS_ACT = 1778 * MiB, WS_END = 1877 * MiB;
static_assert((size_t)NINP * D * 2 == WIN_L && (size_t)M * NP * 2 == 342 * MiB && (size_t)M * D * 4 == 72 * MiB && (size_t)M * FF * 2 == 99 * MiB, "ws map");
constexpr int CW_BAR = 4096;

constexpr int LDS_MAIN = 155648, MISC_OFF = LDS_MAIN, LDS_BYTES = LDS_MAIN + 256;

__device__ __forceinline__ float bf2f(unsigned v) { return __uint_as_float(v << 16); }
__device__ __forceinline__ float bflo(unsigned v) { return __uint_as_float(v << 16); }
__device__ __forceinline__ float bfhi(unsigned v) { return __uint_as_float(v & 0xffff0000u); }
typedef __bf16 bf16x2_t __attribute__((ext_vector_type(2)));
__device__ __forceinline__ unsigned pk2(float lo, float hi) { f32x2 v = {lo, hi}; bf16x2_t b = __builtin_convertvector(v, bf16x2_t); return __builtin_bit_cast(unsigned, b); }
__device__ __forceinline__ bf16 f2bf(float f) { return (bf16)(pk2(f, 0.f) & 0xffffu); }
__device__ __forceinline__ float wave_sum(float v) {
#pragma unroll
    for (int o = 1; o < 64; o <<= 1) v += __shfl_xor(v, o);
    return v;
}
__device__ __forceinline__ float sigmoidf_(float x) { return 1.0f / (1.0f + __expf(-x)); }
__device__ __forceinline__ float siluf_(float x) { return x / (1.0f + __expf(-x)); }
__device__ __forceinline__ float gelu_tanh(float x) { const float u = 1.5957691216f * (x + 0.044715f * x * x * x); return x / (1.0f + __expf(-u)); }
__device__ __forceinline__ int crow(int r, int hi) { return (r & 3) + 8 * (r >> 2) + 4 * hi; }
#define MFMA32(a, b, c) __builtin_amdgcn_mfma_f32_32x32x16_bf16((a), (b), (c), 0, 0, 0)
#define MFMA16(a, b, c) __builtin_amdgcn_mfma_f32_16x16x32_bf16((a), (b), (c), 0, 0, 0)
typedef short v4i16_t __attribute__((ext_vector_type(4)));
__device__ __forceinline__ s16x4 vtr(LAS unsigned char* p) { return __builtin_bit_cast(s16x4, __builtin_amdgcn_ds_read_tr16_b64_v4i16((LAS v4i16_t*)p)); }
__device__ __forceinline__ bf16x8 cat8(s16x4 lo, s16x4 hi) { return __builtin_shufflevector(lo, hi, 0, 1, 2, 3, 4, 5, 6, 7); }

struct KArgs { const float* in[N_INPUTS]; float* out; unsigned char* ws; int ph_lo, ph_hi; };
struct Frame {
    LAS unsigned char* lds;
    int tid, lane, wave, vcu, G;
    const KArgs* ka;
    unsigned char* ws;
};
__device__ __forceinline__ void refresh(Frame& F) { int t = threadIdx.x; asm volatile("" : "+v"(t)); F.tid = t; F.lane = t & 63; F.wave = __builtin_amdgcn_readfirstlane(t >> 6); }
}

namespace pg8 {
__device__ __forceinline__ float ep_sigmoid(float x) { return 1.0f / (1.0f + __expf(-x)); }
struct EpiProj {
    static constexpr bool PERM = true, AFTER_DRAIN = false;
    bf16_t* P; float* DEC;
    __device__ __forceinline__ void operator()(const f32x4 (&acc)[2][2][4][2], const Unit& u, int wr, int wc, int fr, int fq) const {
        const int row0 = u.pm * BM + wr * 64 + fr;
        if (u.pn < 76) {
            const int col0 = u.pn * BM + wc * 32 + 8 * fq;
#pragma unroll
            for (int ai = 0; ai < 2; ++ai)
#pragma unroll
                for (int m = 0; m < 4; ++m) { bf16_t* rowp = P + (size_t)(row0 + ai * HALF + m * 16) * mk::NP + col0;
#pragma unroll
                    for (int bj = 0; bj < 2; ++bj) { const f32x4 v0 = acc[ai][bj][m][0], v1 = acc[ai][bj][m][1];
                        u32x4 w; w.x = cvt_pk_bf16(v0[0], v0[1]); w.y = cvt_pk_bf16(v0[2], v0[3]); w.z = cvt_pk_bf16(v1[0], v1[1]); w.w = cvt_pk_bf16(v1[2], v1[3]);
                        *(u32x4*)(rowp + bj * HALF) = w; } }
        } else if (wc == 0) {
#pragma unroll
            for (int ai = 0; ai < 2; ++ai)
#pragma unroll
                for (int m = 0; m < 4; ++m) { float* rp = DEC + (size_t)(row0 + ai * HALF + m * 16) * 32 + 8 * fq;
                    *(f32x4*)rp = acc[ai][0][m][0]; *(f32x4*)(rp + 4) = acc[ai][0][m][1]; }
        }
    }
};
struct EpiBranch {
    static constexpr bool PERM = true, AFTER_DRAIN = false;
    const bf16_t* P; const float* bmerge; float* MF; bf16_t* MG;
    __device__ __forceinline__ void operator()(const f32x4 (&acc)[2][2][4][2], const Unit& u, int wr, int wc, int fr, int fq) const {
        const int n = u.pn >> 3, pn = u.pn & 7, pm = u.pm - 36 * n;
        const int row0 = pm * BM + wr * 64 + fr, col0 = pn * BM + wc * 32 + 8 * fq;
        f32x4 bm[2][2];
#pragma unroll
        for (int bj = 0; bj < 2; ++bj)
#pragma unroll
            for (int q = 0; q < 2; ++q) bm[bj][q] = *(const f32x4*)(bmerge + n * 2048 + col0 + bj * HALF + 4 * q);
#pragma unroll
        for (int ai = 0; ai < 2; ++ai)
#pragma unroll
            for (int m = 0; m < 4; ++m) { const size_t row = (size_t)(row0 + ai * HALF + m * 16);
#pragma unroll
                for (int bj = 0; bj < 2; ++bj) { const int col = col0 + bj * HALF;
                    const u32x4 gl = *(const u32x4*)(P + row * mk::NP + mk::C_GATE + n * 2048 + col);
                    f32x4 g0, g1;
                    g0[0] = __uint_as_float(gl.x << 16); g0[1] = __uint_as_float(gl.x & 0xffff0000u); g0[2] = __uint_as_float(gl.y << 16); g0[3] = __uint_as_float(gl.y & 0xffff0000u);
                    g1[0] = __uint_as_float(gl.z << 16); g1[1] = __uint_as_float(gl.z & 0xffff0000u); g1[2] = __uint_as_float(gl.w << 16); g1[3] = __uint_as_float(gl.w & 0xffff0000u);
                    f32x4 v0, v1;
#pragma unroll
                    for (int e = 0; e < 4; ++e) { v0[e] = acc[ai][bj][m][0][e] * ep_sigmoid(g0[e] + bm[bj][0][e]); v1[e] = acc[ai][bj][m][1][e] * ep_sigmoid(g1[e] + bm[bj][1][e]); }
                    float* mf = MF + row * 2048 + col;
                    if (n == 0) { *(f32x4*)mf = v0; *(f32x4*)(mf + 4) = v1; }
                    else if (n == 1) { *(f32x4*)mf = *(const f32x4*)mf + v0; *(f32x4*)(mf + 4) = *(const f32x4*)(mf + 4) + v1; }
                    else { v0 = *(const f32x4*)mf + v0; v1 = *(const f32x4*)(mf + 4) + v1;
                        u32x4 w; w.x = cvt_pk_bf16(v0[0], v0[1]); w.y = cvt_pk_bf16(v0[2], v0[3]); w.z = cvt_pk_bf16(v1[0], v1[1]); w.w = cvt_pk_bf16(v1[2], v1[3]);
                        *(u32x4*)(MG + row * 2048 + col) = w; } } }
    }
};
struct EpiRes {
    static constexpr bool PERM = false, AFTER_DRAIN = false;
    float* H; const float* gate;
    __device__ __forceinline__ void operator()(const f32x4 (&acc)[2][2][4][2], const Unit& u, int wr, int wc, int fr, int fq) const {
        const int b = u.pm / 9, rt = (u.pm - 9 * b) < 8 ? b : 4;
        const int row0 = u.pm * BM + wr * 64 + fr, col0 = u.pn * BM + wc * 32 + 4 * fq;
        f32x4 gv[2][2];
#pragma unroll
        for (int bj = 0; bj < 2; ++bj)
#pragma unroll
            for (int n = 0; n < 2; ++n) gv[bj][n] = *(const f32x4*)(gate + rt * 12288 + col0 + bj * HALF + n * 16);
#pragma unroll
        for (int ai = 0; ai < 2; ++ai)
#pragma unroll
            for (int m = 0; m < 4; ++m) { float* hp = H + (size_t)(row0 + ai * HALF + m * 16) * 2048 + col0;
#pragma unroll
                for (int bj = 0; bj < 2; ++bj)
#pragma unroll
                    for (int n = 0; n < 2; ++n) { float* p = hp + bj * HALF + n * 16; *(f32x4*)p = *(const f32x4*)p + gv[bj][n] * acc[ai][bj][m][n]; } }
    }
};
struct EpiSwiglu {
    static constexpr bool PERM = true, AFTER_DRAIN = false;
    bf16_t* ACT;
    __device__ __forceinline__ void operator()(const f32x4 (&acc)[2][2][4][2], const Unit& u, int wr, int wc, int fr, int fq) const {
        const int row0 = u.pm * BM + wr * 64 + fr, col0 = u.pn * HALF + wc * 32 + 8 * fq;
#pragma unroll
        for (int ai = 0; ai < 2; ++ai)
#pragma unroll
            for (int m = 0; m < 4; ++m) { float v[8];
#pragma unroll
                for (int n = 0; n < 2; ++n)
#pragma unroll
                    for (int e = 0; e < 4; ++e) { const float g = acc[ai][0][m][n][e], up = acc[ai][1][m][n][e]; v[4 * n + e] = g / (1.0f + __expf(-g)) * up; }
                u32x4 w; w.x = cvt_pk_bf16(v[0], v[1]); w.y = cvt_pk_bf16(v[2], v[3]); w.z = cvt_pk_bf16(v[4], v[5]); w.w = cvt_pk_bf16(v[6], v[7]);
                *(u32x4*)(ACT + (size_t)(row0 + ai * HALF + m * 16) * mk::FF + col0) = w; }
    }
};
struct BranchOrder {
    StaticOrder so;
    __device__ void init(int G, int c) { so.init(mk::M, 2048, G, c); }
    __device__ bool next(int i, Unit& u) const { const int it = i / 3, n = i - 3 * it; if (!so.next(it, u)) return false; u.pm += 36 * n; u.pn += 8 * n; return true; }
    __device__ __forceinline__ void a_ready(const Unit&) const {}
    __device__ __forceinline__ void done(const Unit&) const {}
};
}

namespace att {
using namespace mk;
constexpr int DH = 128, NW = 8, QBLK = 32, KVBLK = 64;
constexpr float SCALE = 0.088388347648318440f;
constexpr float THR = 8.f;
constexpr int LDQ = NP, LDK = NP, LDO = D;
constexpr int SHM_V = KVBLK * DH * 2, SHM_K = KVBLK * DH * 2, SHM_ATTN = 2 * SHM_V + 2 * SHM_K + NW * 64 * 4;
#define KSWZ(row, colB) ((row) * 256 + ((colB) ^ (((row) & 7) << 4)))
#define SBAR() __builtin_amdgcn_sched_barrier(0)
__device__ __forceinline__ unsigned cvtpk(float lo, float hi) { unsigned r; asm volatile("v_cvt_pk_bf16_f32 %0, %1, %2" : "=v"(r) : "v"(lo), "v"(hi)); return r; }
__device__ __forceinline__ void partialSM(f32x16& p0, f32x16& p1, float& m_reg, float& mn, float& alpha) {
  constexpr float C = SCALE * 1.4426950408889634f;
  float pmax = p0[0];
#pragma unroll
  for (int r = 1; r < 16; ++r) pmax = fmaxf(pmax, p0[r]);
#pragma unroll
  for (int r = 0; r < 16; ++r) pmax = fmaxf(pmax, p1[r]);
  { auto rr = __builtin_amdgcn_permlane32_swap(__float_as_uint(pmax), __float_as_uint(pmax), false, false);
    pmax = fmaxf(__uint_as_float(rr[0]), __uint_as_float(rr[1])); }
  if (__builtin_expect(__all(pmax - m_reg <= THR / SCALE), 1)) { mn = m_reg; alpha = 1.f; }
  else { mn = fmaxf(m_reg, pmax); alpha = __builtin_amdgcn_exp2f((m_reg - mn) * C); m_reg = mn; }
  float mnC = -mn * C;
#pragma unroll
  for (int r = 0; r < 16; ++r) p0[r] = fmaf(p0[r], C, mnC);
#pragma unroll
  for (int r = 0; r < 16; ++r) p1[r] = fmaf(p1[r], C, mnC);
#pragma unroll
  for (int r = 0; r < 16; ++r) p0[r] = __builtin_amdgcn_exp2f(p0[r]);
}
__device__ __forceinline__ void finishSM(f32x16& p0, f32x16& p1, float alpha, float& l_reg, bf16x8& pa0, bf16x8& pa1, bf16x8& pa2, bf16x8& pa3) {
#pragma unroll
  for (int r = 0; r < 16; ++r) p1[r] = __builtin_amdgcn_exp2f(p1[r]);
  float ps = 0;
#pragma unroll
  for (int r = 0; r < 16; ++r) ps += p0[r];
#pragma unroll
  for (int r = 0; r < 16; ++r) ps += p1[r];
  { auto rr = __builtin_amdgcn_permlane32_swap(__float_as_uint(ps), __float_as_uint(ps), false, false);
    ps = __uint_as_float(rr[0]) + __uint_as_float(rr[1]); }
  l_reg = l_reg * alpha + ps;
#define PK4(P, BASE, OUT) do { unsigned a0 = cvtpk(P[BASE + 0], P[BASE + 1]), a1 = cvtpk(P[BASE + 2], P[BASE + 3]);   \
    unsigned b0 = cvtpk(P[BASE + 4], P[BASE + 5]), b1 = cvtpk(P[BASE + 6], P[BASE + 7]);                              \
    auto r0 = __builtin_amdgcn_permlane32_swap(a0, b0, false, false); auto r1 = __builtin_amdgcn_permlane32_swap(a1, b1, false, false); \
    u32x4 w = {r0[0], r1[0], r0[1], r1[1]}; OUT = *reinterpret_cast<bf16x8*>(&w); } while (0)
  PK4(p0, 0, pa0); PK4(p0, 8, pa1); PK4(p1, 0, pa2); PK4(p1, 8, pa3);
#undef PK4
}
__device__ __forceinline__ void qkt(f32x16& p0, f32x16& p1, const bf16* Ks, const bf16x8* qr, int r32, int hi) {
  p0 = f32x16{}; p1 = f32x16{};
#pragma unroll
  for (int d0 = 0; d0 < 8; ++d0) { int cb = (d0 * 16 + hi * 8) * 2;
    bf16x8 b0 = *reinterpret_cast<const bf16x8*>((const char*)Ks + KSWZ(r32, cb));
    bf16x8 b1 = *reinterpret_cast<const bf16x8*>((const char*)Ks + KSWZ(32 + r32, cb));
    p0 = MFMA32(b0, qr[d0], p0);
    p1 = MFMA32(b1, qr[d0], p1); }
}
__device__ __forceinline__ int v_st(int k, int c) { const int kk = (k & ~0xC) | ((k & 4) << 1) | ((k & 8) >> 1); return ((kk >> 3) * 4 + (c >> 5)) * 512 + ((kk & 7) * 32 + (c & 31)) * 2; }
__device__ __forceinline__ int v_rd_base(int lane) { return ((lane & 3) << 3) | (((lane >> 2) & 3) << 6) | (((lane >> 4) & 1) << 5) | (((lane >> 5) & 1) << 8); }
constexpr int v_rd_off(int d0, int ks, int half) { return d0 * 512 + ks * 4096 + half * 2048; }
template <int OFF> __device__ __forceinline__ s16x4 tr_read(int vb) {
  s16x4 r; asm volatile("ds_read_b64_tr_b16 %0, %1 offset:%2" : "=&v"(r) : "v"(vb), "i"(OFF) : "memory"); return r;
}
template <int D0> __device__ __forceinline__ void pv_one(f32x16& od, int vb, bf16x8 pa0, bf16x8 pa1, bf16x8 pa2, bf16x8 pa3) {
  const s16x4 l0 = tr_read<v_rd_off(D0, 0, 0)>(vb), h0 = tr_read<v_rd_off(D0, 0, 1)>(vb), l1 = tr_read<v_rd_off(D0, 1, 0)>(vb), h1 = tr_read<v_rd_off(D0, 1, 1)>(vb);
  const s16x4 l2 = tr_read<v_rd_off(D0, 2, 0)>(vb), h2 = tr_read<v_rd_off(D0, 2, 1)>(vb), l3 = tr_read<v_rd_off(D0, 3, 0)>(vb), h3 = tr_read<v_rd_off(D0, 3, 1)>(vb);
  asm volatile("s_waitcnt lgkmcnt(0)" ::: "memory"); SBAR();
#define PK(L, H) (bf16x8){L[0], L[1], L[2], L[3], H[0], H[1], H[2], H[3]}
  od = MFMA32(pa0, PK(l0, h0), od);
  od = MFMA32(pa1, PK(l1, h1), od);
  od = MFMA32(pa2, PK(l2, h2), od);
  od = MFMA32(pa3, PK(l3, h3), od);
#undef PK
}
__device__ __forceinline__ void pv_d0(f32x16* o, int vb, bf16x8 pa0, bf16x8 pa1, bf16x8 pa2, bf16x8 pa3) {
  pv_one<0>(o[0], vb, pa0, pa1, pa2, pa3); pv_one<1>(o[1], vb, pa0, pa1, pa2, pa3); pv_one<2>(o[2], vb, pa0, pa1, pa2, pa3); pv_one<3>(o[3], vb, pa0, pa1, pa2, pa3);
}
__device__ __forceinline__ void attn_dense_body(const bf16* __restrict__ Qb, const bf16* __restrict__ Kh, const bf16* __restrict__ Vh, bf16* __restrict__ Ob, int seq, char* lds) {
  int tid_ = threadIdx.x; asm volatile("" : "+v"(tid_));
  const int tid = tid_, wid = tid >> 6, lane = tid & 63, r32 = lane & 31, hi = lane >> 5;
  bf16* V_lds = (bf16*)lds; bf16* K_lds = (bf16*)(lds + 2 * SHM_V);
  float* ws = (float*)(lds + 2 * SHM_V + 2 * SHM_K) + wid * 64; float* li_l = ws; float* al_l = ws + 32;
  float m_reg = -1e30f, l_reg = 0; f32x16 o[4] = {}; bf16x8 qr[8];
  const bf16* Qw = Qb + (long)(wid * QBLK + r32) * LDQ + hi * 8;
#pragma unroll
  for (int d0 = 0; d0 < 8; ++d0) qr[d0] = *reinterpret_cast<const bf16x8*>(Qw + d0 * 16);
  const int sr = tid >> 4, sc = (tid & 15) * 8, vst0 = v_st(sr, sc), vst1 = v_st(32 + sr, sc);
  const int vb0 = (int)(uintptr_t)V_lds + v_rd_base(lane);
  struct { bf16x8 vs0, vs1, ks0, ks1; } sr_[2];
  const unsigned go0 = (unsigned)(sr * LDK + sc), go1 = (unsigned)((32 + sr) * LDK + sc);
#define SLOAD(i, k0) do { const bf16* vb_ = Vh + (long)(k0) * LDK; const bf16* kb_ = Kh + (long)(k0) * LDK; \
    sr_[i].vs0 = *reinterpret_cast<const bf16x8*>(vb_ + go0); sr_[i].vs1 = *reinterpret_cast<const bf16x8*>(vb_ + go1); \
    sr_[i].ks0 = *reinterpret_cast<const bf16x8*>(kb_ + go0); sr_[i].ks1 = *reinterpret_cast<const bf16x8*>(kb_ + go1); } while (0)
#define SWRITE(b, i) do { *(bf16x8*)((char*)V_lds + (b) * SHM_V + vst0) = sr_[i].vs0;          \
    *(bf16x8*)((char*)V_lds + (b) * SHM_V + vst1) = sr_[i].vs1; int kc = sc * 2;               \
    *(bf16x8*)((char*)K_lds + (b) * SHM_K + KSWZ(sr, kc)) = sr_[i].ks0;                       \
    *(bf16x8*)((char*)K_lds + (b) * SHM_K + KSWZ(32 + sr, kc)) = sr_[i].ks1; } while (0)
#define SWAIT() asm volatile("s_waitcnt vmcnt(4)" ::: "memory")
#define RESC(a) do { if (__any((a) < 1.f)) { if (hi == 0) al_l[r32] = (a); asm volatile("s_waitcnt lgkmcnt(0)" ::: "memory"); \
    _Pragma("unroll") for (int d = 0; d < 4; ++d) _Pragma("unroll") for (int r = 0; r < 16; ++r) o[d][r] *= al_l[crow(r, hi)]; } } while (0)
  f32x16 pA0, pA1, pB0, pB1; float mnA, mnB, alA, alB; bf16x8 pa0, pa1, pa2, pa3; const int NT = seq / KVBLK;
  constexpr int SE = 0, SO = 1;
  SLOAD(SE, 0); asm volatile("s_waitcnt vmcnt(0)" ::: "memory"); SWRITE(0, SE); __syncthreads();
  qkt(pA0, pA1, K_lds, qr, r32, hi); partialSM(pA0, pA1, m_reg, mnA, alA);
  SLOAD(SO, KVBLK); if (2 < NT) SLOAD(SE, 2 * KVBLK);
  SWAIT(); SWRITE(1, SO); __syncthreads();
  for (int j = 1; j + 1 < NT; j += 2) {
    SBAR(); qkt(pB0, pB1, (bf16*)((char*)K_lds + SHM_K), qr, r32, hi);
    finishSM(pA0, pA1, alA, l_reg, pa0, pa1, pa2, pa3); SBAR();
    SLOAD(SO, (j + 2) * KVBLK); SBAR();
    pv_d0(o, vb0, pa0, pa1, pa2, pa3); partialSM(pB0, pB1, m_reg, mnB, alB);
    __syncthreads(); SWAIT(); SWRITE(0, SE);
    RESC(alB); __syncthreads();
    SBAR(); qkt(pA0, pA1, K_lds, qr, r32, hi);
    finishSM(pB0, pB1, alB, l_reg, pa0, pa1, pa2, pa3); SBAR();
    if (j + 3 < NT) SLOAD(SE, (j + 3) * KVBLK); SBAR();
    pv_d0(o, vb0 + (int)SHM_V, pa0, pa1, pa2, pa3); partialSM(pA0, pA1, m_reg, mnA, alA);
    __syncthreads(); SWAIT(); SWRITE(1, SO);
    RESC(alA); __syncthreads();
  }
  SBAR(); qkt(pB0, pB1, (bf16*)((char*)K_lds + SHM_K), qr, r32, hi);
  finishSM(pA0, pA1, alA, l_reg, pa0, pa1, pa2, pa3); SBAR();
  pv_d0(o, vb0, pa0, pa1, pa2, pa3); partialSM(pB0, pB1, m_reg, mnB, alB);
  __syncthreads(); RESC(alB);
  finishSM(pB0, pB1, alB, l_reg, pa0, pa1, pa2, pa3); SBAR();
  pv_d0(o, vb0 + (int)SHM_V, pa0, pa1, pa2, pa3);
  if (hi == 0) li_l[r32] = l_reg; asm volatile("s_waitcnt lgkmcnt(0)" ::: "memory");
  float rli[16];
#pragma unroll
  for (int r = 0; r < 16; ++r) rli[r] = __builtin_amdgcn_rcpf(li_l[crow(r, hi)]);
  bf16* Ow = Ob + (long)(wid * QBLK) * LDO; const unsigned oo = (unsigned)(4 * hi * LDO + r32);
#pragma unroll
  for (int r = 0; r < 16; ++r) { const unsigned off = oo + (unsigned)(((r & 3) + 8 * (r >> 2)) * LDO);
#pragma unroll
    for (int d0 = 0; d0 < 4; ++d0) Ow[off + d0 * 32] = f2bf(o[d0][r] * rli[r]); }
#undef SLOAD
#undef SWRITE
#undef SWAIT
#undef RESC
}
}

namespace mk {
#define LDS_WAIT() asm volatile("s_waitcnt lgkmcnt(0)" ::: "memory")

__device__ __forceinline__ void transpose_item(const float* W, size_t ldw, bf16* WT, size_t Kd, int k0, int nsrc0, int ndst0, LAS float* scr, int lane) {
#pragma unroll 8
    for (int i = 0; i < 32; ++i) { const int kk = 2 * i + (lane >> 5); scr[kk * 33 + (lane & 31)] = W[(size_t)(k0 + kk) * ldw + nsrc0 + (lane & 31)]; }
    LDS_WAIT(); asm volatile("" ::: "memory");
    const int c = lane & 7;
#pragma unroll
    for (int j = 0; j < 4; ++j) { const int n = (lane >> 3) + 8 * j; const LAS float* s = scr + (8 * c) * 33 + n;
        u32x4 o; o.x = pk2(s[0 * 33], s[1 * 33]); o.y = pk2(s[2 * 33], s[3 * 33]); o.z = pk2(s[4 * 33], s[5 * 33]); o.w = pk2(s[6 * 33], s[7 * 33]);
        *(u32x4*)(WT + (size_t)(ndst0 + n) * Kd + k0 + 8 * c) = o; }
    LDS_WAIT(); asm volatile("" ::: "memory");
}
constexpr int IT_WIN = 32 * 609, IT_WBR = 3 * 32 * 64, IT_WOUT = 32 * 64, IT_WF1 = 32 * 352, IT_WF2 = 88 * 64, IT_LRU = 512;
constexpr int IT_LAYER = IT_WIN + IT_WBR + IT_WOUT + IT_WF1 + IT_WF2 + IT_LRU;

__device__ __forceinline__ void phase_prologue(Frame& F) {
    refresh(F);
    const int gw = F.vcu * NWAVES + F.wave, NGW = F.G * NWAVES, lane = F.lane;
    LAS float* scr = (LAS float*)(F.lds + F.wave * 16384);
    unsigned char* ws = F.ws;
    for (int it = gw; it < DEPTH * IT_LAYER; it += NGW) {
        const int l = it / IT_LAYER; int r = it - l * IT_LAYER;
        if (r < IT_WIN) { const int kb = r / 609, nb = r - kb * 609, ns = 32 * nb; const int nd = ns < 6144 ? ns : (ns < 6176 ? 19456 + (ns - 6144) : ns - 32);
            transpose_item(F.ka->in[I_WIN] + (size_t)l * D * NIN, NIN, (bf16*)(ws + WS_WIN + l * WIN_L), D, 64 * kb, ns, nd, scr, lane); continue; }
        r -= IT_WIN;
        if (r < IT_WBR) { const int n = r / 2048, rr = r - n * 2048, kb = rr >> 6, nb = rr & 63;
            transpose_item(F.ka->in[I_WBR] + ((size_t)l * 3 + n) * D * D, D, (bf16*)(ws + WS_WBR + l * WBR_L), D, 64 * kb, 32 * nb, n * 2048 + 32 * nb, scr, lane); continue; }
        r -= IT_WBR;
        if (r < IT_WOUT) { const int kb = r >> 6, nb = r & 63;
            transpose_item(F.ka->in[I_WOUT] + (size_t)l * D * D, D, (bf16*)(ws + WS_WOUT + l * WOUT_L), D, 64 * kb, 32 * nb, 32 * nb, scr, lane); continue; }
        r -= IT_WOUT;
        if (r < IT_WF1) { const int kb = r / 352, nb = r - kb * 352, ns = 32 * nb; const int up = ns >= FF ? 1 : 0, j = ns - up * FF; const int nd = (j >> 7) * 256 + up * 128 + (j & 127);
            transpose_item(F.ka->in[I_WF1] + (size_t)l * D * NF1, NF1, (bf16*)(ws + WS_WF1 + l * WF1_L), D, 64 * kb, ns, nd, scr, lane); continue; }
        r -= IT_WF1;
        if (r < IT_WF2) { const int kb = r >> 6, nb = r & 63;
            transpose_item(F.ka->in[I_WF2] + (size_t)l * FF * D, D, (bf16*)(ws + WS_WF2 + l * WF2_L), FF, 64 * kb, 32 * nb, 32 * nb, scr, lane); continue; }
        r -= IT_WF2;
        {
            const int sub = r & 7, mat = r >> 3, gate = mat & 1, n = (mat >> 1) & 15, dir = mat >> 5, kb = sub >> 2, nb = sub & 3;
            const float* W = (gate ? F.ka->in[I_LWI] : F.ka->in[I_LWA]) + (((size_t)l * 2 + dir) * 16 + n) * 128 * 128;
            transpose_item(W, 128, ((bf16*)(F.ws + WS_WL)) + ((size_t)l * 16 + n) * 512 * 128, 128, 64 * kb, 32 * nb, (dir * 2 + gate) * 128 + 32 * nb, scr, lane); }
    }
    for (int i = gw * 64 + lane; i < DEPTH * 224 * 256; i += NGW * 64) { const int l = i / (224 * 256), r = i - l * 224 * 256;
        *(u32x4*)((bf16*)(ws + WS_WIN + l * WIN_L) + (size_t)NIN * D + (size_t)r * 8) = (u32x4){0u, 0u, 0u, 0u}; }
    for (int row = gw; row < M; row += NGW) { const int b = row / TT, t = row - b * TT;
        const f32x4* src = (const f32x4*)(t < TL ? F.ka->in[I_X] + ((size_t)b * TL + t) * D : F.ka->in[I_CTX] + ((size_t)b * LC + (t - TL)) * D);
        f32x4* dst = (f32x4*)(((float*)(F.ws + WS_H)) + (size_t)row * D);
#pragma unroll
        for (int j = 0; j < 8; ++j) dst[lane + 64 * j] = src[lane + 64 * j]; }
    for (int i = gw * 64 + lane; i < TL * 64; i += NGW * 64) { const int t = i >> 6, p = i & 63; const int rr = t >> 6, cc = t & 63;
        const float inv = exp2f(-(float)(p & 31) * (13.287712379549449f / 32.0f)); const float ang = (float)(p < 32 ? rr : cc) * inv;
        ((float*)(F.ws + WS_ROPE))[i] = cosf(ang); ((float*)(F.ws + WS_ROPE))[TL * 64 + i] = sinf(ang); }
    __syncthreads();
    LAS float* SC = (LAS float*)F.lds; LAS float* RED = (LAS float*)(F.lds + 40960);
    for (int i = F.tid; i < 5 * D; i += NTHR) { const int rt = i / D, k = i - rt * D; const float c = rt < 4 ? F.ka->in[I_C][rt * D + k] : F.ka->in[I_CCTX][k]; SC[i] = siluf_(c); }
    __syncthreads();
    for (int u = F.vcu; u < DEPTH * 192; u += F.G) { const int l = u / 192, cb = u - l * 192; const int cg = F.tid & 15, ks = F.tid >> 4;
        const float* wp = F.ka->in[I_WMOD] + ((size_t)l * D + ks * 64) * (6 * D) + cb * 64 + cg * 4;
        f32x4 a0 = {0, 0, 0, 0}, a1 = a0, a2 = a0, a3 = a0, a4 = a0;
#pragma unroll 8
        for (int k = 0; k < 64; ++k) { const f32x4 w = *(const f32x4*)(wp + (size_t)k * (6 * D)); const int kk = ks * 64 + k;
            a0 += SC[kk] * w; a1 += SC[D + kk] * w; a2 += SC[2 * D + kk] * w; a3 += SC[3 * D + kk] * w; a4 += SC[4 * D + kk] * w; }
        *(LAS f32x4*)(RED + (ks * 5 + 0) * 64 + cg * 4) = a0; *(LAS f32x4*)(RED + (ks * 5 + 1) * 64 + cg * 4) = a1; *(LAS f32x4*)(RED + (ks * 5 + 2) * 64 + cg * 4) = a2;
        *(LAS f32x4*)(RED + (ks * 5 + 3) * 64 + cg * 4) = a3; *(LAS f32x4*)(RED + (ks * 5 + 4) * 64 + cg * 4) = a4;
        __syncthreads();
        if (F.tid < 320) { const int rt = F.tid >> 6, c = F.tid & 63; float s = F.ka->in[I_BMOD][(size_t)l * 6 * D + cb * 64 + c];
#pragma unroll 8
            for (int k2 = 0; k2 < 32; ++k2) s += RED[(k2 * 5 + rt) * 64 + c];
            ((float*)(F.ws + WS_MOD))[((size_t)l * 5 + rt) * (6 * D) + cb * 64 + c] = s; }
        __syncthreads();
    }
}

__device__ __forceinline__ void phase_norm(Frame& F, int l, const float* gain, int i_shift, int i_scale) {
    refresh(F);
    const int gw = F.vcu * NWAVES + F.wave, NGW = F.G * NWAVES, lane = F.lane;
    for (int row = gw; row < M; row += NGW) { const int b = row / TT, t = row - b * TT, rt = t < TL ? b : 4;
        const f32x4* hp = (const f32x4*)(((float*)(F.ws + WS_H)) + (size_t)row * D); f32x4 v[8]; float ss = 0.f;
#pragma unroll
        for (int j = 0; j < 8; ++j) { v[j] = hp[lane + 64 * j]; ss += (v[j].x * v[j].x + v[j].y * v[j].y) + (v[j].z * v[j].z + v[j].w * v[j].w); }
        const float rstd = 1.0f / sqrtf(wave_sum(ss) * (1.0f / D) + EPS);
        const float* mod = ((float*)(F.ws + WS_MOD)) + ((size_t)l * 5 + rt) * (6 * D);
        u32x2* up = (u32x2*)(((bf16*)(F.ws + WS_U)) + (size_t)row * D);
#pragma unroll
        for (int j = 0; j < 8; ++j) { const int c4 = lane + 64 * j; const f32x4 g = ((const f32x4*)gain)[c4], sc = ((const f32x4*)(mod + i_scale * D))[c4], sh = ((const f32x4*)(mod + i_shift * D))[c4];
            const f32x4 o = (v[j] * rstd * g) * (sc + 1.0f) + sh; u32x2 w; w.x = pk2(o.x, o.y); w.y = pk2(o.z, o.w); up[c4] = w; } }
}
__device__ __forceinline__ void phase_final(Frame& F) {
    refresh(F);
    const int gw = F.vcu * NWAVES + F.wave, NGW = F.G * NWAVES, lane = F.lane; const float* gain = F.ka->in[I_FNG];
    for (int idx = gw; idx < NB * TL; idx += NGW) { const int b = idx / TL, t = idx - b * TL; const size_t row = (size_t)b * TT + t;
        const f32x4* hp = (const f32x4*)(((float*)(F.ws + WS_H)) + row * D); f32x4 v[8]; float ss = 0.f;
#pragma unroll
        for (int j = 0; j < 8; ++j) { v[j] = hp[lane + 64 * j]; ss += (v[j].x * v[j].x + v[j].y * v[j].y) + (v[j].z * v[j].z + v[j].w * v[j].w); }
        const float rstd = 1.0f / sqrtf(wave_sum(ss) * (1.0f / D) + EPS);
        f32x4* op = (f32x4*)(F.ka->out + (size_t)idx * D);
#pragma unroll
        for (int j = 0; j < 8; ++j) { const int c4 = lane + 64 * j; op[c4] = v[j] * rstd * ((const f32x4*)gain)[c4]; } }
}

__device__ __forceinline__ void prep_attn(Frame& F, int l) {
    refresh(F);
    const int gw = F.vcu * NWAVES + F.wave, NGW = F.G * NWAVES, lane = F.lane;
    const float gq0 = F.ka->in[I_QNG][l * 128 + 2 * lane], gq1 = F.ka->in[I_QNG][l * 128 + 2 * lane + 1], gk0 = F.ka->in[I_KNG][l * 128 + 2 * lane], gk1 = F.ka->in[I_KNG][l * 128 + 2 * lane + 1];
    for (int row = gw; row < M; row += NGW) { const int t = row % TT; const bool lat = t < TL;
        unsigned* base = (unsigned*)(((bf16*)(F.ws + WS_PROJ)) + (size_t)row * NP + C_AQ) + lane;
        float cs = 1.f, sn = 0.f; if (lat) { cs = ((float*)(F.ws + WS_ROPE))[t * 64 + lane]; sn = ((float*)(F.ws + WS_ROPE))[TL * 64 + t * 64 + lane]; }
        unsigned x[20];
#pragma unroll
        for (int h = 0; h < 20; ++h) x[h] = base[h * 64];
#pragma unroll
        for (int h = 0; h < 20; ++h) { const float x1 = bflo(x[h]), x2 = bfhi(x[h]); const float ss = wave_sum(x1 * x1 + x2 * x2);
            const float rstd = 1.0f / sqrtf(ss * (1.0f / 128.0f) + EPS); const float y1 = x1 * rstd * (h < 16 ? gq0 : gk0), y2 = x2 * rstd * (h < 16 ? gq1 : gk1);
            base[h * 64] = pk2(y1 * cs - y2 * sn, y1 * sn + y2 * cs); } }
}
__device__ __forceinline__ void prep_gla(Frame& F, int l) {
    refresh(F);
    LAS float* DECs = (LAS float*)F.lds;
    const int tid = F.tid, dir = tid >> 8, cp = tid & 255;
    for (int u = F.vcu; u < 288; u += F.G) { const int b = u / 72, rem = u - b * 72, c = rem >> 1, half = rem & 1; const size_t R0 = (size_t)b * TT + 64 * c;
        __syncthreads();
        *(LAS f32x4*)(DECs + tid * 4) = *(const f32x4*)(((float*)(F.ws + WS_DEC)) + R0 * 32 + tid * 4);
        __syncthreads();
        const int k0 = half * 512 + 2 * cp;
        f32x2 wv[16];
#pragma unroll
        for (int r = 0; r < 16; ++r) wv[r] = *(const f32x2*)(F.ka->in[I_GWD] + (((size_t)l * 2 + dir) * 16 + r) * 1024 + k0);
        const f32x2 bd = *(const f32x2*)(F.ka->in[I_GBD] + ((size_t)l * 2 + dir) * 1024 + k0);
        f32x2 run = {0.f, 0.f};
#define GLA_LA(t_, la_) do { f32x2 z = bd; _Pragma("unroll") for (int r = 0; r < 16; ++r) z += DECs[(t_) * 32 + dir * 16 + r] * wv[r]; \
            la_.x = (fminf(z.x, 0.f) - __logf(1.0f + __expf(-fabsf(z.x)))) * 0.0625f; la_.y = (fminf(z.y, 0.f) - __logf(1.0f + __expf(-fabsf(z.y)))) * 0.0625f; } while (0)
#pragma unroll 4
        for (int i = 0; i < 64; ++i) { const int t = dir ? 63 - i : i; f32x2 la; GLA_LA(t, la); run += la; }
        const f32x2 tot = run;
        { f32x2 dl; dl.x = __expf(tot.x); dl.y = __expf(tot.y); *(f32x2*)(((float*)(F.ws + WS_DL)) + ((size_t)dir * 144 + b * 36 + c) * 1024 + k0) = dl; }
        bf16* QDp = ((bf16*)(F.ws + WS_QD)) + (size_t)dir * M * 1024; bf16* KNp = ((bf16*)(F.ws + WS_QD)) + (size_t)(2 + dir) * M * 1024; bf16* KDp = ((bf16*)(F.ws + WS_QD)) + (size_t)(4 + dir) * M * 1024;
        run = (f32x2){0.f, 0.f};
#pragma unroll 4
        for (int i = 0; i < 64; ++i) { const int t = dir ? 63 - i : i; const size_t row = R0 + t; f32x2 la; GLA_LA(t, la); run += la;
            const unsigned q2 = *(const unsigned*)(((bf16*)(F.ws + WS_PROJ)) + row * NP + C_GQ + k0), k2 = *(const unsigned*)(((bf16*)(F.ws + WS_PROJ)) + row * NP + C_GK + k0);
            const float e0 = __expf(run.x), e1 = __expf(run.y), n0 = __expf(-run.x), n1 = __expf(-run.y), d0 = __expf(tot.x - run.x), d1 = __expf(tot.y - run.y);
            const float q0 = bflo(q2) * 0.0625f, q1 = bfhi(q2) * 0.0625f, kk0 = bflo(k2), kk1 = bfhi(k2);
            *(unsigned*)(QDp + row * 1024 + k0) = pk2(q0 * e0, q1 * e1);
            *(unsigned*)(KNp + row * 1024 + k0) = pk2(kk0 * n0, kk1 * n1);
            *(unsigned*)(KDp + row * 1024 + k0) = pk2(kk0 * d0, kk1 * d1); }
#undef GLA_LA
    }
}
__device__ __forceinline__ void prep_lru(Frame& F, int l) {
    refresh(F);
    constexpr int XBS = 272, XFS = 528, O_XF = 64 * XBS;
    LAS unsigned char* lds = F.lds;
    const int tid = F.tid, lane = F.lane, wv = F.wave, i16 = lane & 15, g4 = lane >> 4;
    const int n = F.vcu & 15, slot = F.vcu >> 4, nslot = F.G >> 4;
    bf16x8 Bf[4][4];
#pragma unroll
    for (int gi = 0; gi < 4; ++gi)
#pragma unroll
        for (int ks = 0; ks < 4; ++ks) Bf[gi][ks] = *(const bf16x8*)(((bf16*)(F.ws + WS_WL)) + (((size_t)l * 16 + n) * 512 + gi * 128 + 16 * wv + i16) * 128 + 32 * ks + 8 * g4);
    const int C = 128 * n + 16 * wv + i16;
    float ba[2], bi[2], sp8[2];
#pragma unroll
    for (int d = 0; d < 2; ++d) { ba[d] = F.ka->in[I_LBA][((size_t)l * 2 + d) * D + C]; bi[d] = F.ka->in[I_LBI][((size_t)l * 2 + d) * D + C];
        const float lam = F.ka->in[I_LAM][((size_t)l * 2 + d) * D + C]; sp8[d] = 8.0f * (fmaxf(-lam, 0.f) + __logf(1.0f + __expf(-fabsf(lam)))); }
    const int cgp = tid & 15, tk = tid >> 4; const int cch = 128 * n + 8 * cgp;
    for (int tt = slot; tt < M / 64; tt += nslot) { const int R0 = 64 * tt, b = R0 / TT, tq = R0 - b * TT;
        const int seq_lo = tq < TL ? b * TT : b * TT + TL, seq_hi = tq < TL ? b * TT + TL : (b + 1) * TT;
        f32x4 cw[4][2], cbv[2];
#pragma unroll
        for (int j = 0; j < 4; ++j) { cw[j][0] = *(const f32x4*)(F.ka->in[I_CW] + ((size_t)l * 4 + j) * D + cch); cw[j][1] = *(const f32x4*)(F.ka->in[I_CW] + ((size_t)l * 4 + j) * D + cch + 4); }
        cbv[0] = *(const f32x4*)(F.ka->in[I_CB] + (size_t)l * D + cch); cbv[1] = *(const f32x4*)(F.ka->in[I_CB] + (size_t)l * D + cch + 4);
#pragma unroll
        for (int q = 0; q < 2; ++q) { const int tok = tk + 32 * q, row = R0 + tok; f32x4 a0 = cbv[0], a1 = cbv[1];
#pragma unroll
            for (int j = 0; j < 4; ++j) { const int rr = row + j - 2; u32x4 xv = {0u, 0u, 0u, 0u};
                if (rr >= seq_lo && rr < seq_hi) xv = *(const u32x4*)(((bf16*)(F.ws + WS_PROJ)) + (size_t)rr * NP + C_LX + cch);
                f32x4 x0 = {bflo(xv.x), bfhi(xv.x), bflo(xv.y), bfhi(xv.y)}, x1 = {bflo(xv.z), bfhi(xv.z), bflo(xv.w), bfhi(xv.w)};
                a0 += cw[j][0] * x0; a1 += cw[j][1] * x1; }
            *(LAS f32x4*)(lds + O_XF + tok * XFS + cgp * 32) = a0; *(LAS f32x4*)(lds + O_XF + tok * XFS + cgp * 32 + 16) = a1;
            u32x4 w; w.x = pk2(a0.x, a0.y); w.y = pk2(a0.z, a0.w); w.z = pk2(a1.x, a1.y); w.w = pk2(a1.z, a1.w);
            *(LAS u32x4*)(lds + tok * XBS + cgp * 16) = w; }
        __syncthreads();
        f32x4 acc[4][4];
#pragma unroll
        for (int tb = 0; tb < 4; ++tb)
#pragma unroll
            for (int gi = 0; gi < 4; ++gi) acc[tb][gi] = (f32x4){0.f, 0.f, 0.f, 0.f};
#pragma unroll
        for (int tb = 0; tb < 4; ++tb)
#pragma unroll
            for (int ks = 0; ks < 4; ++ks) { const bf16x8 a = *(const LAS bf16x8*)(lds + (16 * tb + i16) * XBS + (32 * ks + 8 * g4) * 2);
#pragma unroll
                for (int gi = 0; gi < 4; ++gi) acc[tb][gi] = MFMA16(a, Bf[gi][ks], acc[tb][gi]); }
        const int first0 = b * TT + TL, first1 = b * TT + TL + LC - 1;
#pragma unroll
        for (int tb = 0; tb < 4; ++tb)
#pragma unroll
            for (int rg = 0; rg < 4; ++rg) { const int tok = 16 * tb + 4 * g4 + rg, row = R0 + tok; const float x = *(const LAS float*)(lds + O_XF + tok * XFS + (16 * wv + i16) * 4);
#pragma unroll
                for (int d = 0; d < 2; ++d) { const float r = sigmoidf_(acc[tb][2 * d][rg] + ba[d]), ig = sigmoidf_(acc[tb][2 * d + 1][rg] + bi[d]);
                    const float la = -r * sp8[d], a = __expf(la); float mult = sqrtf(fmaxf(1.0f - a * a, 0.f)); if (row == (d ? first1 : first0)) mult = 1.0f;
                    ((bf16*)(F.ws + WS_LA))[((size_t)d * M + row) * D + C] = f2bf(la); ((bf16*)(F.ws + WS_LA))[((size_t)(2 + d) * M + row) * D + C] = f2bf(mult * ig * x); } }
        __syncthreads();
    }
}

__device__ __forceinline__ void gla_unit(Frame& F, int unit) {
    refresh(F);
    constexpr int QS = 528, KS = 576, AS = 144;
    constexpr int O_QD = 0, O_KN = 33792, O_KD = 67584, O_V = 104448, O_ATT = 141312, O_DL = 150528;
    LAS unsigned char* lds = F.lds;
    const int tid = F.tid, lane = F.lane, wv = F.wave, r32 = lane & 31, hh = lane >> 5, i16 = lane & 15, g4 = lane >> 4;
    const int b = unit >> 4, hd = (unit >> 2) & 3, dir = (unit >> 1) & 1, half = unit & 1;
    const bf16* gQD = ((bf16*)(F.ws + WS_QD)) + (size_t)dir * M * 1024 + hd * 256; const bf16* gKN = ((bf16*)(F.ws + WS_QD)) + (size_t)(2 + dir) * M * 1024 + hd * 256; const bf16* gKD = ((bf16*)(F.ws + WS_QD)) + (size_t)(4 + dir) * M * 1024 + hd * 256;
    const bf16* gV = ((bf16*)(F.ws + WS_PROJ)) + C_GV + hd * 512 + half * 256;
    bf16* gO = (dir ? ((bf16*)(F.ws + WS_OB)) : ((bf16*)(F.ws + WS_OF))) + hd * 512 + half * 256 + 32 * wv;
    const float* gDL = ((float*)(F.ws + WS_DL)) + ((size_t)dir * 144 + b * 36) * 1024 + hd * 256;
    f32x16 S[8];
#pragma unroll
    for (int i = 0; i < 8; ++i) S[i] = f32x16{};
    for (int s = 0; s < 36; ++s) {
        const int c = dir ? 35 - s : (s < 4 ? 32 + s : s - 4); const size_t R0 = (size_t)b * TT + 64 * c;
        { const unsigned vq = (unsigned)((tid >> 5) * 1024 + 8 * (tid & 31)), vv = (unsigned)((tid >> 5) * NP + 8 * (tid & 31));
          LAS unsigned char* lq = lds + (tid >> 5) * QS + 16 * (tid & 31); LAS unsigned char* lk = lds + (tid >> 5) * KS + 16 * (tid & 31);
#pragma unroll
          for (int i = 0; i < 4; ++i) {
            const bf16* bq = gQD + (R0 + 16 * i) * 1024; const bf16* bn = gKN + (R0 + 16 * i) * 1024; const bf16* bk = gKD + (R0 + 16 * i) * 1024; const bf16* bv = gV + (R0 + 16 * i) * NP;
            const u32x4 q = *(const u32x4*)(bq + vq), kn = *(const u32x4*)(bn + vq), kd = *(const u32x4*)(bk + vq), v = *(const u32x4*)(bv + vv);
            *(LAS u32x4*)(lq + O_QD + i * 16 * QS) = q; *(LAS u32x4*)(lq + O_KN + i * 16 * QS) = kn;
            *(LAS u32x4*)(lk + O_KD + i * 16 * KS) = kd; *(LAS u32x4*)(lk + O_V + i * 16 * KS) = v;
            if (i == 1) asm volatile("" ::: "memory"); } }
        if (tid < 64) *(LAS f32x4*)(lds + O_DL + tid * 16) = *(const f32x4*)(gDL + (size_t)c * 1024 + tid * 4);
        __syncthreads();
        { const int ib = wv >> 1, jb0 = 2 * (wv & 1); f32x4 at0 = {0.f, 0.f, 0.f, 0.f}, at1 = at0;
#pragma unroll
            for (int ks = 0; ks < 8; ++ks) { const int cb = (32 * ks + 8 * g4) * 2;
                const bf16x8 a = *(const LAS bf16x8*)(lds + O_QD + (16 * ib + i16) * QS + cb);
                const bf16x8 b0 = *(const LAS bf16x8*)(lds + O_KN + (16 * jb0 + i16) * QS + cb), b1 = *(const LAS bf16x8*)(lds + O_KN + (16 * (jb0 + 1) + i16) * QS + cb);
                at0 = MFMA16(a, b0, at0); at1 = MFMA16(a, b1, at1); }
#pragma unroll
            for (int rg = 0; rg < 4; ++rg) { const int i = 16 * ib + 4 * g4 + rg, j0 = 16 * jb0 + i16, j1 = j0 + 16;
                const bool k0 = dir ? (j0 >= i) : (j0 <= i), k1 = dir ? (j1 >= i) : (j1 <= i);
                *(LAS bf16*)(lds + O_ATT + i * AS + j0 * 2) = k0 ? f2bf(at0[rg]) : (bf16)0; *(LAS bf16*)(lds + O_ATT + i * AS + j1 * 2) = k1 ? f2bf(at1[rg]) : (bf16)0; } }
        f32x16 o0 = f32x16{}, o1 = f32x16{};
#pragma unroll
        for (int dkb = 0; dkb < 8; ++dkb)
#pragma unroll
            for (int st = 0; st < 2; ++st) { u32x4 pb; pb.x = pk2(S[dkb][8 * st + 0], S[dkb][8 * st + 1]); pb.y = pk2(S[dkb][8 * st + 2], S[dkb][8 * st + 3]);
                pb.z = pk2(S[dkb][8 * st + 4], S[dkb][8 * st + 5]); pb.w = pk2(S[dkb][8 * st + 6], S[dkb][8 * st + 7]); const bf16x8 bfr = __builtin_bit_cast(bf16x8, pb);
                const int dko = (32 * dkb + 16 * st + 4 * hh) * 2;
                const s16x4 l0 = *(const LAS s16x4*)(lds + O_QD + r32 * QS + dko), h0 = *(const LAS s16x4*)(lds + O_QD + r32 * QS + dko + 16);
                const s16x4 l1 = *(const LAS s16x4*)(lds + O_QD + (32 + r32) * QS + dko), h1 = *(const LAS s16x4*)(lds + O_QD + (32 + r32) * QS + dko + 16);
                o0 = MFMA32(cat8(l0, h0), bfr, o0); o1 = MFMA32(cat8(l1, h1), bfr, o1); }
        __syncthreads();
        bf16x8 Vf[4];
#pragma unroll
        for (int ks = 0; ks < 4; ++ks) { LAS unsigned char* p = lds + O_V + (16 * ks + 8 * hh + (i16 >> 2)) * KS + (32 * wv + 16 * (g4 & 1) + 4 * (i16 & 3)) * 2;
            Vf[ks] = cat8(vtr(p), vtr(p + 4 * KS)); }
#pragma unroll
        for (int ks = 0; ks < 4; ++ks) { const int cb = (16 * ks + 8 * hh) * 2;
            const bf16x8 a0 = *(const LAS bf16x8*)(lds + O_ATT + r32 * AS + cb), a1 = *(const LAS bf16x8*)(lds + O_ATT + (32 + r32) * AS + cb);
            o0 = MFMA32(a0, Vf[ks], o0); o1 = MFMA32(a1, Vf[ks], o1); }
        { bf16* ob = gO + R0 * D; const unsigned lo_ = (unsigned)(4 * hh * D + r32);
#pragma unroll
          for (int rg = 0; rg < 16; ++rg) { const unsigned off = lo_ + (unsigned)(((rg & 3) + 8 * (rg >> 2)) * D);
            ob[off] = f2bf(o0[rg]); ob[off + 32 * D] = f2bf(o1[rg]); } }
#pragma unroll
        for (int dkb = 0; dkb < 8; ++dkb) {
#pragma unroll
            for (int q = 0; q < 4; ++q) { const f32x4 dl = *(const LAS f32x4*)(lds + O_DL + (32 * dkb + 8 * q + 4 * hh) * 4);
                S[dkb][4 * q + 0] *= dl.x; S[dkb][4 * q + 1] *= dl.y; S[dkb][4 * q + 2] *= dl.z; S[dkb][4 * q + 3] *= dl.w; }
#pragma unroll
            for (int ks = 0; ks < 4; ++ks) { LAS unsigned char* p = lds + O_KD + (16 * ks + 8 * hh + (i16 >> 2)) * KS + (32 * dkb + 16 * (g4 & 1) + 4 * (i16 & 3)) * 2;
                S[dkb] = MFMA32(cat8(vtr(p), vtr(p + 4 * KS)), Vf[ks], S[dkb]); } }
        __syncthreads();
    }
}
__device__ __forceinline__ void lru_scan_unit(Frame& F, int unit) {
    refresh(F);
    LAS f32x4* SEG = (LAS f32x4*)F.lds;
    const int b = unit >> 5, d = (unit >> 4) & 1, g = unit & 15, cp = F.lane, seg = F.wave, ch = 128 * g + 2 * cp;
    const bf16* la = ((bf16*)(F.ws + WS_LA)) + (size_t)d * M * D + ch; const bf16* bx = ((bf16*)(F.ws + WS_LA)) + (size_t)(2 + d) * M * D + ch; bf16* hs = ((bf16*)(F.ws + WS_HS)) + (size_t)d * M * D + ch;
    const int p0 = 288 * seg;
#define LRU_ROW(p) ((size_t)b * TT + (d == 0 ? ((p) < LC ? TL + (p) : (p) - LC) : ((p) < LC ? TL + LC - 1 - (p) : TL - 1 - ((p) - LC))))
    float h0 = 0.f, h1 = 0.f, A0 = 1.f, A1 = 1.f;
#pragma unroll 8
    for (int i = 0; i < 288; ++i) { const size_t row = LRU_ROW(p0 + i); const unsigned lv = *(const unsigned*)(la + row * D), bv = *(const unsigned*)(bx + row * D);
        const float a0 = __expf(bflo(lv)), a1 = __expf(bfhi(lv)); h0 = a0 * h0 + bflo(bv); h1 = a1 * h1 + bfhi(bv); A0 *= a0; A1 *= a1; }
    __syncthreads();
    SEG[seg * 64 + cp] = (f32x4){A0, h0, A1, h1};
    __syncthreads();
    h0 = 0.f; h1 = 0.f;
    for (int s2 = 0; s2 < seg; ++s2) { const f32x4 v = SEG[s2 * 64 + cp]; h0 = v.x * h0 + v.y; h1 = v.z * h1 + v.w; }
#pragma unroll 8
    for (int i = 0; i < 288; ++i) { const size_t row = LRU_ROW(p0 + i); const unsigned lv = *(const unsigned*)(la + row * D), bv = *(const unsigned*)(bx + row * D);
        const float a0 = __expf(bflo(lv)), a1 = __expf(bfhi(lv)); h0 = a0 * h0 + bflo(bv); h1 = a1 * h1 + bfhi(bv); *(unsigned*)(hs + row * D) = pk2(h0, h1); }
#undef LRU_ROW
    __syncthreads();
}
__device__ __forceinline__ void attn_unit_latent(Frame& F, int idx) {
    const int qb = idx & 7, g = (idx >> 3) & 3, kvh = (idx >> 5) & 3, b = idx >> 7, h = kvh * 4 + g;
    const size_t r0 = (size_t)b * TT + 256 * qb, k0 = (size_t)b * TT;
    att::attn_dense_body(((bf16*)(F.ws + WS_PROJ)) + r0 * NP + C_AQ + h * 128, ((bf16*)(F.ws + WS_PROJ)) + k0 * NP + C_AK + kvh * 128, ((bf16*)(F.ws + WS_PROJ)) + k0 * NP + C_AV + kvh * 128, ((bf16*)(F.ws + WS_OBR)) + (size_t)M * D + r0 * D + h * 128, TT, (char*)F.lds);
    __syncthreads();
}
__device__ __forceinline__ void attn_unit_ctx(Frame& F, int idx) {
    const int h = idx & 15, b = idx >> 4, kvh = h >> 2; const size_t r0 = (size_t)b * TT + TL;
    att::attn_dense_body(((bf16*)(F.ws + WS_PROJ)) + r0 * NP + C_AQ + h * 128, ((bf16*)(F.ws + WS_PROJ)) + r0 * NP + C_AK + kvh * 128, ((bf16*)(F.ws + WS_PROJ)) + r0 * NP + C_AV + kvh * 128, ((bf16*)(F.ws + WS_OBR)) + (size_t)M * D + r0 * D + h * 128, LC, (char*)F.lds);
    __syncthreads();
}
__device__ __forceinline__ void phase_mix(Frame& F) {
    const int w = F.vcu;
    if (w < 64) { if constexpr (EN(6)) gla_unit(F, w); return; }
    const int w2 = w - 64, NA = F.G - 64;
    if constexpr (EN(7)) for (int idx = w2; idx < 512; idx += NA) attn_unit_latent(F, idx);
    for (int it = NA - 1 - w2; it < 192; it += NA) { if (it < 64) { if constexpr (EN(7)) attn_unit_ctx(F, it); } else { if constexpr (EN(8)) lru_scan_unit(F, it - 64); } }
}

__device__ __forceinline__ void phase_post(Frame& F, int l) {
    refresh(F);
    const int gw = F.vcu * NWAVES + F.wave, NGW = F.G * NWAVES, lane = F.lane;
    f32x4 gn0 = *(const f32x4*)(F.ka->in[I_GNG] + l * 512 + 8 * lane), gn1 = *(const f32x4*)(F.ka->in[I_GNG] + l * 512 + 8 * lane + 4);
    for (int row = gw; row < M; row += NGW) {
#pragma unroll
        for (int hd = 0; hd < 4; ++hd) { const int col = hd * 512 + 8 * lane;
            const u32x4 a = *(const u32x4*)(((bf16*)(F.ws + WS_OF)) + (size_t)row * D + col), bb = *(const u32x4*)(((bf16*)(F.ws + WS_OB)) + (size_t)row * D + col), rr = *(const u32x4*)(((bf16*)(F.ws + WS_PROJ)) + (size_t)row * NP + C_GR + col);
            float o[8] = {bflo(a.x) + bflo(bb.x), bfhi(a.x) + bfhi(bb.x), bflo(a.y) + bflo(bb.y), bfhi(a.y) + bfhi(bb.y), bflo(a.z) + bflo(bb.z), bfhi(a.z) + bfhi(bb.z), bflo(a.w) + bflo(bb.w), bfhi(a.w) + bfhi(bb.w)};
            const float r[8] = {bflo(rr.x), bfhi(rr.x), bflo(rr.y), bfhi(rr.y), bflo(rr.z), bfhi(rr.z), bflo(rr.w), bfhi(rr.w)};
            float ss = 0.f;
#pragma unroll
            for (int e = 0; e < 8; ++e) ss += o[e] * o[e];
            const float rstd = 1.0f / sqrtf(wave_sum(ss) * (1.0f / 512.0f) + EPS);
            const float gn[8] = {gn0.x, gn0.y, gn0.z, gn0.w, gn1.x, gn1.y, gn1.z, gn1.w};
#pragma unroll
            for (int e = 0; e < 8; ++e) o[e] = o[e] * rstd * gn[e] * siluf_(r[e]);
            u32x4 w; w.x = pk2(o[0], o[1]); w.y = pk2(o[2], o[3]); w.z = pk2(o[4], o[5]); w.w = pk2(o[6], o[7]);
            *(u32x4*)(((bf16*)(F.ws + WS_OBR)) + (size_t)row * D + col) = w; }
#pragma unroll
        for (int j = 0; j < 4; ++j) { const int col = j * 512 + 8 * lane;
            const u32x4 a = *(const u32x4*)(((bf16*)(F.ws + WS_HS)) + (size_t)row * D + col), bb = *(const u32x4*)(((bf16*)(F.ws + WS_HS)) + ((size_t)M + row) * D + col), yy = *(const u32x4*)(((bf16*)(F.ws + WS_PROJ)) + (size_t)row * NP + C_LY + col);
            float o[8] = {bflo(a.x) + bflo(bb.x), bfhi(a.x) + bfhi(bb.x), bflo(a.y) + bflo(bb.y), bfhi(a.y) + bfhi(bb.y), bflo(a.z) + bflo(bb.z), bfhi(a.z) + bfhi(bb.z), bflo(a.w) + bflo(bb.w), bfhi(a.w) + bfhi(bb.w)};
            const float y[8] = {bflo(yy.x), bfhi(yy.x), bflo(yy.y), bfhi(yy.y), bflo(yy.z), bfhi(yy.z), bflo(yy.w), bfhi(yy.w)};
#pragma unroll
            for (int e = 0; e < 8; ++e) o[e] *= gelu_tanh(y[e]);
            u32x4 w; w.x = pk2(o[0], o[1]); w.y = pk2(o[2], o[3]); w.z = pk2(o[4], o[5]); w.w = pk2(o[6], o[7]);
            *(u32x4*)(((bf16*)(F.ws + WS_OBR)) + ((size_t)2 * M + row) * D + col) = w; }
    }
}
}

using namespace mk;
constexpr int N_PHASES = 42;
typedef KArgs Args;

__global__ void __launch_bounds__(NTHR, 2) hybrid_fwd(Args args) {
    extern __shared__ __attribute__((aligned(16))) unsigned char lds_raw[];
    Frame F;
    F.lds = (LAS unsigned char*)lds_raw;
    F.tid = threadIdx.x; F.lane = F.tid & 63; F.wave = __builtin_amdgcn_readfirstlane(F.tid >> 6);
    F.G = gridDim.x; { const int bx = blockIdx.x; F.vcu = (F.G % 8 == 0) ? (bx % 8) * (F.G / 8) + bx / 8 : bx; }
    F.ka = &args; F.ws = args.ws;
    unsigned char* ws = args.ws;
    volatile LAS unsigned* MISC = (volatile LAS unsigned*)(F.lds + MISC_OFF);
    if (F.tid < 64) MISC[F.tid] = 0u;
    __syncthreads();
    const int lo = args.ph_lo, hi = args.ph_hi;
    XcdBarrier bar; bar.bar = (unsigned*)(ws + WS_CTL) + CW_BAR; bar.x = 0; bar.st = nullptr;
    if (hi - lo > 1) bar = xcd_barrier_post((unsigned*)(ws + WS_CTL) + CW_BAR, MISC + 8);
#define IN(k) (lo <= (k) && (k) < hi)
#define SEAM(k) do { if (hi > (k) + 1) xcd_barrier(bar); } while (0)
    const int c_id = (int)blockIdx.x;

    if (IN(0)) { if constexpr (EN(0)) phase_prologue(F); SEAM(0); }
    for (int l = 0; l < DEPTH; ++l) {
        const int pb = 1 + 10 * l;
        const float* modl = ((float*)(F.ws + WS_MOD)) + (size_t)l * 5 * (6 * D);
        if (IN(pb + 0)) { if constexpr (EN(1)) phase_norm(F, l, F.ka->in[I_NMIX] + (size_t)l * D, 0, 1); SEAM(pb + 0); }
        if (IN(pb + 1)) {
            pg8::Gemm g{((bf16*)(F.ws + WS_U)), (const bf16*)(ws + WS_WIN + l * WIN_L), M, NINP, D}; pg8::StaticOrder S; S.init(M, NINP, F.G, c_id);
            pg8::EpiProj E{((bf16*)(F.ws + WS_PROJ)), ((float*)(F.ws + WS_DEC))};
            if constexpr (EN(2)) pg8::gemm_phase<pg8::EpiProj, pg8::StaticOrder, true, true>(F.lds, g, S, E);
            SEAM(pb + 1); }
        if (IN(pb + 2)) { if constexpr (EN(3)) prep_attn(F, l); if constexpr (EN(4)) prep_gla(F, l); __syncthreads(); if constexpr (EN(5)) prep_lru(F, l); SEAM(pb + 2); }
        if (IN(pb + 3)) { phase_mix(F); SEAM(pb + 3); }
        if (IN(pb + 4)) { if constexpr (EN(9)) phase_post(F, l); SEAM(pb + 4); }
        if (IN(pb + 5)) {
            pg8::Gemm g{((bf16*)(F.ws + WS_OBR)), (const bf16*)(ws + WS_WBR + l * WBR_L), 3 * M, 3 * D, D}; pg8::BranchOrder S; S.init(F.G, c_id);
            pg8::EpiBranch E{((bf16*)(F.ws + WS_PROJ)), F.ka->in[I_BMERGE] + (size_t)l * 3 * D, ((float*)(F.ws + WS_MF)), ((bf16*)(F.ws + WS_MG))};
            if constexpr (EN(10)) pg8::gemm_phase<pg8::EpiBranch, pg8::BranchOrder, true, true>(F.lds, g, S, E);
            SEAM(pb + 5); }
        if (IN(pb + 6)) {
            pg8::Gemm g{((bf16*)(F.ws + WS_MG)), (const bf16*)(ws + WS_WOUT + l * WOUT_L), M, D, D}; pg8::StaticOrder S; S.init(M, D, F.G, c_id);
            pg8::EpiRes E{((float*)(F.ws + WS_H)), modl + 2 * D};
            if constexpr (EN(11)) pg8::gemm_phase<pg8::EpiRes, pg8::StaticOrder, true, true>(F.lds, g, S, E);
            SEAM(pb + 6); }
        if (IN(pb + 7)) { phase_norm(F, l, F.ka->in[I_NFFN] + (size_t)l * D, 3, 4); SEAM(pb + 7); }
        if (IN(pb + 8)) {
            pg8::Gemm g{((bf16*)(F.ws + WS_U)), (const bf16*)(ws + WS_WF1 + l * WF1_L), M, NF1, D}; pg8::StaticOrder S; S.init(M, NF1, F.G, c_id);
            pg8::EpiSwiglu E{((bf16*)(F.ws + WS_ACT))};
            if constexpr (EN(12)) pg8::gemm_phase<pg8::EpiSwiglu, pg8::StaticOrder, true, true>(F.lds, g, S, E);
            SEAM(pb + 8); }
        if (IN(pb + 9)) {
            pg8::Gemm g{((bf16*)(F.ws + WS_ACT)), (const bf16*)(ws + WS_WF2 + l * WF2_L), M, D, FF}; pg8::StaticOrder S; S.init(M, D, F.G, c_id);
            pg8::EpiRes E{((float*)(F.ws + WS_H)), modl + 5 * D};
            if constexpr (EN(13)) pg8::gemm_phase<pg8::EpiRes, pg8::StaticOrder, true, true>(F.lds, g, S, E);
            SEAM(pb + 9); }
    }
    if (IN(41)) { if constexpr (EN(14)) phase_final(F); }
#undef IN
#undef SEAM
}

#ifndef MK_LAUNCH_PER_PHASE
#define MK_LAUNCH_PER_PHASE 1
#endif
extern "C" void kernel_launch(void* const* d_in, const int* in_sizes, int n_in, void* d_out, int out_size, void* d_ws, size_t ws_size, hipStream_t stream) {
    static int grid = 0;
    if (grid == 0) {
        if (n_in != N_INPUTS || out_size != NB * TL * D || ws_size < WS_END) { fprintf(stderr, "kernel_launch: shape mismatch n_in %d out %d ws %zu (need %zu)\n", n_in, out_size, ws_size, (size_t)WS_END); grid = -1; return; }
        int dev = 0, cus = 0, per_cu = 0;
        if (hipGetDevice(&dev) != hipSuccess || hipDeviceGetAttribute(&cus, hipDeviceAttributeMultiprocessorCount, dev) != hipSuccess) { grid = -1; return; }
        if (hipFuncSetAttribute((const void*)hybrid_fwd, hipFuncAttributeMaxDynamicSharedMemorySize, LDS_BYTES) != hipSuccess) { fprintf(stderr, "kernel_launch: hipFuncSetAttribute failed\n"); grid = -1; return; }
        if (hipOccupancyMaxActiveBlocksPerMultiprocessor(&per_cu, (const void*)hybrid_fwd, NTHR, LDS_BYTES) != hipSuccess || per_cu < 1) fprintf(stderr, "kernel_launch: occupancy query says %d\n", per_cu);
        (void)hipGetLastError();
        grid = cus;
        if (grid != 256) fprintf(stderr, "kernel_launch: %d CUs (built for 256)\n", grid);
    }
    if (grid < 0) return;
    (void)hipMemsetAsync((char*)d_ws + WS_CTL, 0, CTL_ZERO_BYTES, stream);
    Args a{};
    for (int i = 0; i < N_INPUTS; ++i) a.in[i] = (const float*)d_in[i];
    a.out = (float*)d_out; a.ws = (unsigned char*)d_ws;
#if MK_LAUNCH_PER_PHASE
    for (int p = 0; p < N_PHASES; ++p) { a.ph_lo = p; a.ph_hi = p + 1; hipLaunchKernelGGL(hybrid_fwd, dim3(grid), dim3(NTHR), LDS_BYTES, stream, a); }
#else
    a.ph_lo = 0; a.ph_hi = N_PHASES; hipLaunchKernelGGL(hybrid_fwd, dim3(grid), dim3(NTHR), LDS_BYTES, stream, a);
#endif
    const hipError_t le = hipPeekAtLastError();
    if (le != hipSuccess) fprintf(stderr, "kernel_launch: launch failed: %s\n", hipGetErrorName(le));
}
```

```cpp
#include <hip/hip_runtime.h>
#include <hip/hip_bf16.h>
#include <cstdio>
#include <cstdint>
#define LAS __attribute__((address_space(3)))
#define GAS __attribute__((address_space(1)))
namespace pg8 {
#define PG8_LAS __attribute__((address_space(3)))
typedef unsigned short bf16_t;
typedef short bf16x8 __attribute__((ext_vector_type(8)));
typedef float f32x4 __attribute__((ext_vector_type(4)));
typedef unsigned u32x4 __attribute__((ext_vector_type(4)));
constexpr int BM = 256, BK = 64, HALF = 128, HTB = HALF * BK * 2  , STAGE_BYTES = 8 * HTB, NXCD = 8, WGM = 8;

__host__ __device__ __forceinline__ int lds_byte(int r, int c) { const int st = (r >> 4) * 2 + (c >> 5), rr = r & 15, cc = c & 31, ob = rr * 64 + cc * 2; return st * 1024 + (ob ^ (((ob >> 9) & 1) << 5)); }
__host__ __device__ __forceinline__ void stage_rc(int b, int& R, int& C) { const int st = b / 1024, sb = b % 1024, swz = sb ^ (((sb >> 9) & 1) << 5); R = (st >> 1) * 16 + swz / 64; C = (st & 1) * 32 + (swz % 64) / 2; }
__host__ __device__ __forceinline__ int perm32(int rho) { const int n = rho >> 4, i = rho & 15; return 8 * (i >> 2) + 4 * n + (i & 3); }

struct Unit { int pm, pn; };
struct Gemm { const bf16_t* A; const bf16_t* Bt; int M, N, K; };

struct StaticOrder {
    int nM, nN, nwg, G, c;
    __host__ __device__ void init(int M, int N, int G_, int c_) { nM = M / BM; nN = N / BM; nwg = nM * nN; G = G_; c = c_; }
    __host__ __device__ bool next(int i, Unit& u) const {
        const long L = (long)i * G + c; if (L >= nwg) return false;
        int wgid = (int)L; { const int q = nwg / NXCD, r = nwg % NXCD, xcd = wgid % NXCD, off = wgid / NXCD; wgid = (xcd < r ? xcd * (q + 1) : r * (q + 1) + (xcd - r) * q) + off; }
        const int nig = WGM * nN, gid = wgid / nig, fm = gid * WGM, gsz = (nM - fm) < WGM ? (nM - fm) : WGM;
        u.pm = fm + ((wgid % nig) % gsz); u.pn = (wgid % nig) / gsz; return true;
    }
    __device__ __forceinline__ void a_ready(const Unit&) const {}
    __device__ __forceinline__ void done(const Unit&) const {}
};

__device__ __forceinline__ unsigned cvt_pk_bf16(float lo, float hi) { unsigned r; asm volatile("v_cvt_pk_bf16_f32 %0, %1, %2" : "=v"(r) : "v"(lo), "v"(hi)); return r; }
template <class Epi, class Sched, bool ALIGN_EPI = false, bool SP2 = false>
__device__ __forceinline__ void gemm_phase(PG8_LAS unsigned char* lds, const Gemm g, const Sched& S, const Epi& E) {
    int tid_ = threadIdx.x; asm volatile("" : "+v"(tid_));
    const int tid = tid_, wid = __builtin_amdgcn_readfirstlane(tid >> 6), lane = tid & 63, wr = wid >> 2, wc = wid & 3, fr = lane & 15, fq = lane >> 4;
    const int K = g.K, nt = K / BK;
    unsigned voffA[2], voffB[2];
#pragma unroll
    for (int i = 0; i < 2; ++i) { int R, C; stage_rc(tid * 16 + i * 8192, R, C); const int Rb = Epi::PERM ? ((R & ~31) + perm32(R & 31)) : R;
        voffA[i] = (unsigned)(R * K + C) * 2u; voffB[i] = (unsigned)(Rb * K + C) * 2u; }
    const size_t kstep = (size_t)(BK * 2);
    const size_t hstep = (size_t)HALF * K * 2;
    const size_t tstep = 2 * hstep;
    const unsigned ldsw = (unsigned)wid * 1024u;
    const int aoff = lds_byte(wr * 64 + fr, fq * 8), boff = lds_byte(wc * 32 + fr, fq * 8);
#define PG8_SA(b, h) (((b) * 2 + (h)) * HTB)
#define PG8_SB(b, h) ((4 + (b) * 2 + (h)) * HTB)
#define PG8_STAGE(bufoff, gbase, voff) do { _Pragma("unroll") for (int _i = 0; _i < 2; ++_i) \
        __builtin_amdgcn_global_load_lds((const unsigned*)((const char*)(gbase) + (voff)[_i]), (PG8_LAS unsigned*)(lds + (bufoff) + ldsw + _i * 8192), 16, 0, 0); } while (0)
#define PG8_LDA(dst, b, h) do { _Pragma("unroll") for (int m = 0; m < 4; ++m) _Pragma("unroll") for (int k = 0; k < 2; ++k) dst[m][k] = *(const PG8_LAS bf16x8*)(lds + PG8_SA(b, h) + aoff + m * 2048 + k * 1024); } while (0)
#define PG8_LDB(dst, b, h) do { _Pragma("unroll") for (int n = 0; n < 2; ++n) _Pragma("unroll") for (int k = 0; k < 2; ++k) dst[n][k] = *(const PG8_LAS bf16x8*)(lds + PG8_SB(b, h) + boff + n * 2048 + k * 1024); } while (0)
#define PG8_MMA(ai, bj, At, Bt) do { __builtin_amdgcn_s_setprio(1); _Pragma("unroll") for (int m = 0; m < 4; ++m) _Pragma("unroll") for (int n = 0; n < 2; ++n) _Pragma("unroll") for (int k = 0; k < 2; ++k) \
        acc[ai][bj][m][n] = __builtin_amdgcn_mfma_f32_16x16x32_bf16(Bt[n][k], At[m][k], acc[ai][bj][m][n], 0, 0, 0); __builtin_amdgcn_s_setprio(0); } while (0)
#define PG8_WAIT_V(n) asm volatile("s_waitcnt vmcnt(" #n ")" ::: "memory")
#define PG8_WAIT_L(n) asm volatile("s_waitcnt lgkmcnt(" #n ")" ::: "memory")
#define PG8_BAR __builtin_amdgcn_s_barrier()
#define PG8_SCHED __builtin_amdgcn_sched_barrier(0)
    Unit cur, nxt; int ui = 0;
    if (!S.next(0, cur)) return;
    f32x4 acc[2][2][4][2];
#pragma unroll
    for (int a = 0; a < 2; ++a)
#pragma unroll
        for (int b = 0; b < 2; ++b)
#pragma unroll
            for (int m = 0; m < 4; ++m)
#pragma unroll
                for (int n = 0; n < 2; ++n) acc[a][b][m][n] = (f32x4){0.f, 0.f, 0.f, 0.f};
    bf16x8 At[4][2], B0[2][2], B1[2][2];
    const char* cA = (const char*)g.A + (size_t)cur.pm * tstep; const char* cB = (const char*)g.Bt + (size_t)cur.pn * tstep;
    S.a_ready(cur);
    if constexpr (SP2) {
        PG8_STAGE(PG8_SB(0, 0), cB, voffB); PG8_STAGE(PG8_SB(0, 1), cB + hstep, voffB); PG8_STAGE(PG8_SA(0, 0), cA, voffA); PG8_STAGE(PG8_SA(0, 1), cA + hstep, voffA);
        if (wr == 1) PG8_BAR;
        PG8_WAIT_V(2); PG8_BAR;
        PG8_STAGE(PG8_SB(1, 0), cB + kstep, voffB); PG8_STAGE(PG8_SA(1, 0), cA + kstep, voffA); PG8_STAGE(PG8_SB(1, 1), cB + hstep + kstep, voffB);
        PG8_WAIT_V(6); PG8_BAR;
    } else {
        PG8_STAGE(PG8_SB(0, 0), cB, voffB); PG8_STAGE(PG8_SA(0, 0), cA, voffA); PG8_STAGE(PG8_SB(0, 1), cB + hstep, voffB); PG8_STAGE(PG8_SA(0, 1), cA + hstep, voffA);
        if (wr == 1) PG8_BAR;
        PG8_WAIT_V(4); PG8_BAR;
        PG8_STAGE(PG8_SB(1, 0), cB + kstep, voffB); PG8_STAGE(PG8_SA(1, 0), cA + kstep, voffA); PG8_STAGE(PG8_SB(1, 1), cB + hstep + kstep, voffB);
        PG8_WAIT_V(6); PG8_BAR;
    }
    for (;;) {
        const bool has_next = S.next(ui + 1, nxt);
        const char* nA = has_next ? (const char*)g.A + (size_t)nxt.pm * tstep : cA; const char* nB = has_next ? (const char*)g.Bt + (size_t)nxt.pn * tstep : cB;
        for (int t = 0; t < nt; t += 2) {
            const bool last = (t == nt - 2);
            const char* a1 = cA + (size_t)(t + 1) * kstep;
            const char* a2 = last ? nA : cA + (size_t)(t + 2) * kstep; const char* b2 = last ? nB : cB + (size_t)(t + 2) * kstep;
            const char* a3 = a2 + kstep; const char* b3 = b2 + kstep;
            if (last && has_next) S.a_ready(nxt);
            if constexpr (SP2) {
            PG8_LDB(B0, 0, 0); PG8_LDB(B1, 0, 1); PG8_SCHED; PG8_LDA(At, 0, 0); PG8_STAGE(PG8_SA(1, 1), a1 + hstep, voffA);
            PG8_WAIT_V(8); PG8_WAIT_L(0); PG8_BAR; PG8_MMA(0, 0, At, B0); PG8_MMA(0, 1, At, B1); PG8_BAR; PG8_SCHED;
            PG8_LDA(At, 0, 1); PG8_STAGE(PG8_SB(0, 0), b2, voffB); PG8_STAGE(PG8_SB(0, 1), b2 + hstep, voffB); PG8_STAGE(PG8_SA(0, 0), a2, voffA);
            PG8_WAIT_V(8); PG8_WAIT_L(0); PG8_BAR; PG8_MMA(1, 0, At, B0); PG8_MMA(1, 1, At, B1); PG8_BAR; PG8_SCHED;
            PG8_LDB(B0, 1, 0); PG8_LDB(B1, 1, 1); PG8_SCHED; PG8_LDA(At, 1, 0); PG8_STAGE(PG8_SA(0, 1), a2 + hstep, voffA);
            PG8_WAIT_V(8); PG8_WAIT_L(0); PG8_BAR; PG8_MMA(0, 0, At, B0); PG8_MMA(0, 1, At, B1); PG8_BAR; PG8_SCHED;
            PG8_LDA(At, 1, 1); PG8_STAGE(PG8_SB(1, 0), b3, voffB); PG8_STAGE(PG8_SB(1, 1), b3 + hstep, voffB); PG8_STAGE(PG8_SA(1, 0), a3, voffA);
            PG8_WAIT_V(8); PG8_WAIT_L(0); PG8_BAR; PG8_MMA(1, 0, At, B0); PG8_MMA(1, 1, At, B1); PG8_BAR; PG8_SCHED;
            } else {
            PG8_LDB(B0, 0, 0); PG8_SCHED; PG8_LDA(At, 0, 0); PG8_STAGE(PG8_SA(1, 1), a1 + hstep, voffA);
            PG8_WAIT_L(8); PG8_BAR; PG8_WAIT_L(0); PG8_MMA(0, 0, At, B0); PG8_BAR; PG8_SCHED;
            PG8_LDB(B1, 0, 1); PG8_STAGE(PG8_SB(0, 0), b2, voffB);
            PG8_BAR; PG8_WAIT_L(0); PG8_MMA(0, 1, At, B1); PG8_BAR;
            PG8_LDA(At, 0, 1); PG8_STAGE(PG8_SA(0, 0), a2, voffA);
            PG8_BAR; PG8_WAIT_L(0); PG8_MMA(1, 0, At, B0); PG8_BAR; PG8_SCHED;
            PG8_STAGE(PG8_SB(0, 1), b2 + hstep, voffB);
            PG8_WAIT_V(6); PG8_BAR; PG8_MMA(1, 1, At, B1); PG8_BAR;
            PG8_LDB(B0, 1, 0); PG8_SCHED; PG8_LDA(At, 1, 0); PG8_STAGE(PG8_SA(0, 1), a2 + hstep, voffA);
            PG8_WAIT_L(8); PG8_BAR; PG8_WAIT_L(0); PG8_MMA(0, 0, At, B0); PG8_BAR; PG8_SCHED;
            PG8_LDB(B1, 1, 1); PG8_STAGE(PG8_SB(1, 0), b3, voffB);
            PG8_BAR; PG8_WAIT_L(0); PG8_MMA(0, 1, At, B1); PG8_BAR;
            PG8_LDA(At, 1, 1); PG8_STAGE(PG8_SA(1, 0), a3, voffA);
            PG8_BAR; PG8_WAIT_L(0); PG8_MMA(1, 0, At, B0); PG8_BAR; PG8_SCHED;
            PG8_STAGE(PG8_SB(1, 1), b3 + hstep, voffB);
            PG8_WAIT_V(6); PG8_BAR; PG8_MMA(1, 1, At, B1); PG8_BAR;
            }
        }
        if constexpr (ALIGN_EPI) { if (wr == 0) PG8_BAR; }
        if constexpr (!Epi::AFTER_DRAIN) { E(acc, cur, wr, wc, fr, fq); S.done(cur); }
        if (!has_next) break;
#pragma unroll
        for (int a = 0; a < 2; ++a)
#pragma unroll
            for (int b = 0; b < 2; ++b)
#pragma unroll
                for (int m = 0; m < 4; ++m)
#pragma unroll
                    for (int n = 0; n < 2; ++n) acc[a][b][m][n] = (f32x4){0.f, 0.f, 0.f, 0.f};
        cur = nxt; cA = nA; cB = nB; ++ui;
        if constexpr (ALIGN_EPI) { if (wr == 1) PG8_BAR; }
    }
    PG8_WAIT_V(0);
    if constexpr (!ALIGN_EPI) { if (wr == 0) PG8_BAR; }
    PG8_BAR;
    if constexpr (Epi::AFTER_DRAIN) { E.fused(acc, cur, wr, wc, fr, fq, lds, wid, lane); S.done(cur); }
#undef PG8_SA
#undef PG8_SB
#undef PG8_STAGE
#undef PG8_LDA
#undef PG8_LDB
#undef PG8_MMA
#undef PG8_WAIT_V
#undef PG8_WAIT_L
#undef PG8_BAR
#undef PG8_SCHED
}
}
#define XB_TMO      128
#define XB_XCNT(j)  (256  + 64 * (j))
#define XB_XSUB(j)  (1280 + 64 * (j))
#define XB_XGEN(j)  (2304 + 64 * (j))
#define XB_TOP      3328
#define XB_TOPGEN   3392
#define XCD_BAR_WORDS 3456
#define XB_SPIN_CAP (1u << 18)

__device__ __forceinline__ unsigned xb_ld(unsigned* p)              { return __hip_atomic_load(p, __ATOMIC_RELAXED, __HIP_MEMORY_SCOPE_AGENT); }
__device__ __forceinline__ unsigned xb_add(unsigned* p, unsigned v) { return __hip_atomic_fetch_add(p, v, __ATOMIC_RELAXED, __HIP_MEMORY_SCOPE_AGENT); }
__device__ __forceinline__ unsigned xb_xcc_id() { return (unsigned)__builtin_amdgcn_s_getreg((3 << 11) | 20) & 0xFu; }
#define XB_SPIN(cond, bar) do { unsigned _sp = 0; while (cond) { __builtin_amdgcn_s_sleep(1); \
    if ((++_sp & 255u) == 0u) { if (xb_ld(&(bar)[XB_TMO])) break; if (_sp > XB_SPIN_CAP) { atomicAdd(&(bar)[XB_TMO], 1u); break; } } } } while (0)

struct XcdBarrier {
    unsigned* bar; unsigned x;
    volatile LAS unsigned* st;
};

__device__ __forceinline__ XcdBarrier xcd_barrier_post(unsigned* bar, volatile LAS unsigned* st) {
    XcdBarrier b; b.bar = bar; b.x = xb_xcc_id(); b.st = st;
    if (threadIdx.x == 0) (void)xb_add(&bar[XB_XCNT(b.x)], 1u);
    return b;
}
__device__ __forceinline__ void xcd_barrier_complete(unsigned* bar, unsigned x, unsigned& nloc, unsigned& nx) {
    const unsigned G = gridDim.x * gridDim.y * gridDim.z;
    unsigned sum, cnt, mine, sp = 0u;
    for (;;) {
        sum = 0u; cnt = 0u; mine = 0u;
#pragma unroll
        for (unsigned j = 0; j < 16; ++j) { const unsigned c = xb_ld(&bar[XB_XCNT(j)]); sum += c; cnt += (c > 0u) ? 1u : 0u; mine = (j == x) ? c : mine; }
        if (sum == G) break;
        __builtin_amdgcn_s_sleep(1);
        if ((++sp & 255u) == 0u) { if (xb_ld(&bar[XB_TMO])) break; if (sp > XB_SPIN_CAP) { atomicAdd(&bar[XB_TMO], 1u); break; } }
    }
    nloc = mine > 0u ? mine : 1u; nx = cnt > 0u ? cnt : 1u;
}

__device__ __forceinline__ void xcd_barrier(const XcdBarrier& b) {
    asm volatile("s_waitcnt vmcnt(0)" ::: "memory");
    __syncthreads();
    if (threadIdx.x == 0) {
        unsigned* bar = b.bar;
        __builtin_amdgcn_s_waitcnt(0);
        unsigned nloc = b.st[0], nx = b.st[1];
        if (nloc == 0u) { xcd_barrier_complete(bar, b.x, nloc, nx); b.st[0] = nloc; b.st[1] = nx; }
        const unsigned old = xb_add(&bar[XB_XSUB(b.x)], 1u);
        const unsigned gen = old / nloc;
        if (old + 1u == (gen + 1u) * nloc) {
            __builtin_amdgcn_fence(__ATOMIC_RELEASE, "agent");
            asm volatile("s_waitcnt vmcnt(0)" ::: "memory");
            const unsigned og = xb_add(&bar[XB_TOP], 1u);
            const unsigned tg = og / nx;
            if (og + 1u == (tg + 1u) * nx) xb_add(&bar[XB_TOPGEN], 1u);
            else XB_SPIN(xb_ld(&bar[XB_TOPGEN]) == tg, bar);
            __builtin_amdgcn_fence(__ATOMIC_ACQUIRE, "agent");
            xb_add(&bar[XB_XGEN(b.x)], 1u);
            asm volatile("s_waitcnt vmcnt(0)" ::: "memory");
        } else {
            XB_SPIN(xb_ld(&bar[XB_XGEN(b.x)]) == gen, bar);
            __builtin_amdgcn_fence(__ATOMIC_ACQUIRE, "agent");
            asm volatile("s_waitcnt vmcnt(0)" ::: "memory");
        }
    }
    __syncthreads();
}
#ifndef PH_MASK
#define PH_MASK 0xFFFFFFFFu
#endif
#define EN(k) (((PH_MASK) >> (k)) & 1u)
namespace mk {
typedef unsigned short bf16;
typedef short bf16x8 __attribute__((ext_vector_type(8)));
typedef short s16x4 __attribute__((ext_vector_type(4)));
typedef float f32x2 __attribute__((ext_vector_type(2)));
typedef float f32x4 __attribute__((ext_vector_type(4)));
typedef float f32x16 __attribute__((ext_vector_type(16)));
typedef unsigned u32x2 __attribute__((ext_vector_type(2)));
typedef unsigned u32x4 __attribute__((ext_vector_type(4)));

constexpr int D = 2048, NB = 4, TL = 2048, LC = 256, TT = 2304, M = NB * TT, DEPTH = 4;
constexpr int NIN = 19488, NP = 19456, NINP = 19712, FF = 5632, NF1 = 11264;
constexpr int C_GQ = 0, C_GK = 1024, C_GV = 2048, C_GR = 4096, C_AQ = 6144, C_AK = 8192, C_AV = 8704, C_LX = 9216, C_LY = 11264, C_GATE = 13312;
constexpr float EPS = 1e-6f;
constexpr int NWAVES = 8, NTHR = 512;

enum { I_X = 0, I_C, I_CTX, I_CCTX, I_WMOD, I_BMOD, I_NMIX, I_NFFN, I_WIN, I_GWD, I_GBD, I_GNG, I_QNG, I_KNG, I_CW, I_CB, I_LWA, I_LBA, I_LWI, I_LBI, I_LAM, I_BMERGE, I_WBR, I_WOUT,
       I_WF1, I_WF2, I_FNG, N_INPUTS };

constexpr size_t MiB = 1u << 20;
constexpr size_t WS_CTL = 0, CTL_ZERO_BYTES = 1 * MiB;
constexpr size_t WS_MOD = 1 * MiB, WS_ROPE = 2 * MiB, WS_DEC = 4 * MiB, WS_DL = 6 * MiB, WS_WL = 8 * MiB;
constexpr size_t WS_WIN = 16 * MiB, WIN_L = 77 * MiB;
constexpr size_t WS_WBR = 324 * MiB, WBR_L = 24 * MiB;
constexpr size_t WS_WOUT = 420 * MiB, WOUT_L = 8 * MiB;
constexpr size_t WS_WF1 = 452 * MiB, WF1_L = 44 * MiB;
constexpr size_t WS_WF2 = 628 * MiB, WF2_L = 22 * MiB;
constexpr size_t WS_H = 716 * MiB, WS_U = 788 * MiB, WS_PROJ = 824 * MiB;
constexpr size_t WS_QD = 1166 * MiB, QD_ONE = 18 * MiB;
constexpr size_t WS_OF = 1274 * MiB, WS_OB = 1310 * MiB;
constexpr size_t WS_LA = 1346 * MiB, ACT36 = 36 * MiB;
constexpr size_t WS_HS = 1490 * MiB;
constexpr size_t WS_OBR = 1562 * MiB;
constexpr size_t WS_MF = 1670 * MiB, WS_MG = 1742 * MiB, WS_ACT = 1778 * MiB, WS_END = 1877 * MiB;
static_assert((size_t)NINP * D * 2 == WIN_L && (size_t)M * NP * 2 == 342 * MiB && (size_t)M * D * 4 == 72 * MiB && (size_t)M * FF * 2 == 99 * MiB, "ws map");
constexpr int CW_BAR = 4096;

constexpr int LDS_MAIN = 155648, MISC_OFF = LDS_MAIN, LDS_BYTES = LDS_MAIN + 256;

__device__ __forceinline__ float bf2f(unsigned v) { return __uint_as_float(v << 16); }
__device__ __forceinline__ float bflo(unsigned v) { return __uint_as_float(v << 16); }
__device__ __forceinline__ float bfhi(unsigned v) { return __uint_as_float(v & 0xffff0000u); }
typedef __bf16 bf16x2_t __attribute__((ext_vector_type(2)));
__device__ __forceinline__ unsigned pk2(float lo, float hi) { f32x2 v = {lo, hi}; bf16x2_t b = __builtin_convertvector(v, bf16x2_t); return __builtin_bit_cast(unsigned, b); }
__device__ __forceinline__ bf16 f2bf(float f) { return (bf16)(pk2(f, 0.f) & 0xffffu); }
__device__ __forceinline__ float wave_sum(float v) {
#pragma unroll
    for (int o = 1; o < 64; o <<= 1) v += __shfl_xor(v, o);
    return v;
}
__device__ __forceinline__ float sigmoidf_(float x) { return 1.0f / (1.0f + __expf(-x)); }
__device__ __forceinline__ float siluf_(float x) { return x / (1.0f + __expf(-x)); }
__device__ __forceinline__ float gelu_tanh(float x) { const float u = 1.5957691216f * (x + 0.044715f * x * x * x); return x / (1.0f + __expf(-u)); }
__device__ __forceinline__ int crow(int r, int hi) { return (r & 3) + 8 * (r >> 2) + 4 * hi; }
#define MFMA32(a, b, c) __builtin_amdgcn_mfma_f32_32x32x16_bf16((a), (b), (c), 0, 0, 0)
#define MFMA16(a, b, c) __builtin_amdgcn_mfma_f32_16x16x32_bf16((a), (b), (c), 0, 0, 0)
typedef short v4i16_t __attribute__((ext_vector_type(4)));
__device__ __forceinline__ s16x4 vtr(LAS unsigned char* p) { return __builtin_bit_cast(s16x4, __builtin_amdgcn_ds_read_tr16_b64_v4i16((LAS v4i16_t*)p)); }
__device__ __forceinline__ bf16x8 cat8(s16x4 lo, s16x4 hi) { return __builtin_shufflevector(lo, hi, 0, 1, 2, 3, 4, 5, 6, 7); }

struct KArgs { const float* in[N_INPUTS]; float* out; unsigned char* ws; int ph_lo, ph_hi; };
struct Frame {
    LAS unsigned char* lds;
    int tid, lane, wave, vcu, G;
    const KArgs* ka;
    unsigned char* ws;
};
__device__ __forceinline__ void refresh(Frame& F) { int t = threadIdx.x; asm volatile("" : "+v"(t)); F.tid = t; F.lane = t & 63; F.wave = __builtin_amdgcn_readfirstlane(t >> 6); }
}

namespace pg8 {
__device__ __forceinline__ float ep_sigmoid(float x) { return 1.0f / (1.0f + __expf(-x)); }
struct EpiProj {
    static constexpr bool PERM = true, AFTER_DRAIN = false;
    bf16_t* P; float* DEC;
    __device__ __forceinline__ void operator()(const f32x4 (&acc)[2][2][4][2], const Unit& u, int wr, int wc, int fr, int fq) const {
        const int row0 = u.pm * BM + wr * 64 + fr;
        if (u.pn < 76) {
            const int col0 = u.pn * BM + wc * 32 + 8 * fq;
#pragma unroll
            for (int ai = 0; ai < 2; ++ai)
#pragma unroll
                for (int m = 0; m < 4; ++m) { bf16_t* rowp = P + (size_t)(row0 + ai * HALF + m * 16) * mk::NP + col0;
#pragma unroll
                    for (int bj = 0; bj < 2; ++bj) { const f32x4 v0 = acc[ai][bj][m][0], v1 = acc[ai][bj][m][1];
                        u32x4 w; w.x = cvt_pk_bf16(v0[0], v0[1]); w.y = cvt_pk_bf16(v0[2], v0[3]); w.z = cvt_pk_bf16(v1[0], v1[1]); w.w = cvt_pk_bf16(v1[2], v1[3]);
                        *(u32x4*)(rowp + bj * HALF) = w; } }
        } else if (wc == 0) {
#pragma unroll
            for (int ai = 0; ai < 2; ++ai)
#pragma unroll
                for (int m = 0; m < 4; ++m) { float* rp = DEC + (size_t)(row0 + ai * HALF + m * 16) * 32 + 8 * fq;
                    *(f32x4*)rp = acc[ai][0][m][0]; *(f32x4*)(rp + 4) = acc[ai][0][m][1]; }
        }
    }
};
struct EpiBranch {
    static constexpr bool PERM = true, AFTER_DRAIN = false;
    const bf16_t* P; const float* bmerge; float* MF; bf16_t* MG;
    __device__ __forceinline__ void operator()(const f32x4 (&acc)[2][2][4][2], const Unit& u, int wr, int wc, int fr, int fq) const {
        const int n = u.pn >> 3, pn = u.pn & 7, pm = u.pm - 36 * n;
        const int row0 = pm * BM + wr * 64 + fr, col0 = pn * BM + wc * 32 + 8 * fq;
        f32x4 bm[2][2];
#pragma unroll
        for (int bj = 0; bj < 2; ++bj)
#pragma unroll
            for (int q = 0; q < 2; ++q) bm[bj][q] = *(const f32x4*)(bmerge + n * 2048 + col0 + bj * HALF + 4 * q);
#pragma unroll
        for (int ai = 0; ai < 2; ++ai)
#pragma unroll
            for (int m = 0; m < 4; ++m) { const size_t row = (size_t)(row0 + ai * HALF + m * 16);
#pragma unroll
                for (int bj = 0; bj < 2; ++bj) { const int col = col0 + bj * HALF;
                    const u32x4 gl = *(const u32x4*)(P + row * mk::NP + mk::C_GATE + n * 2048 + col);
                    f32x4 g0, g1;
                    g0[0] = __uint_as_float(gl.x << 16); g0[1] = __uint_as_float(gl.x & 0xffff0000u); g0[2] = __uint_as_float(gl.y << 16); g0[3] = __uint_as_float(gl.y & 0xffff0000u);
                    g1[0] = __uint_as_float(gl.z << 16); g1[1] = __uint_as_float(gl.z & 0xffff0000u); g1[2] = __uint_as_float(gl.w << 16); g1[3] = __uint_as_float(gl.w & 0xffff0000u);
                    f32x4 v0, v1;
#pragma unroll
                    for (int e = 0; e < 4; ++e) { v0[e] = acc[ai][bj][m][0][e] * ep_sigmoid(g0[e] + bm[bj][0][e]); v1[e] = acc[ai][bj][m][1][e] * ep_sigmoid(g1[e] + bm[bj][1][e]); }
                    float* mf = MF + row * 2048 + col;
                    if (n == 0) { *(f32x4*)mf = v0; *(f32x4*)(mf + 4) = v1; }
                    else if (n == 1) { *(f32x4*)mf = *(const f32x4*)mf + v0; *(f32x4*)(mf + 4) = *(const f32x4*)(mf + 4) + v1; }
                    else { v0 = *(const f32x4*)mf + v0; v1 = *(const f32x4*)(mf + 4) + v1;
                        u32x4 w; w.x = cvt_pk_bf16(v0[0], v0[1]); w.y = cvt_pk_bf16(v0[2], v0[3]); w.z = cvt_pk_bf16(v1[0], v1[1]); w.w = cvt_pk_bf16(v1[2], v1[3]);
                        *(u32x4*)(MG + row * 2048 + col) = w; } } }
    }
};
struct EpiRes {
    static constexpr bool PERM = false, AFTER_DRAIN = false;
    float* H; const float* gate;
    __device__ __forceinline__ void operator()(const f32x4 (&acc)[2][2][4][2], const Unit& u, int wr, int wc, int fr, int fq) const {
        const int b = u.pm / 9, rt = (u.pm - 9 * b) < 8 ? b : 4;
        const int row0 = u.pm * BM + wr * 64 + fr, col0 = u.pn * BM + wc * 32 + 4 * fq;
        f32x4 gv[2][2];
#pragma unroll
        for (int bj = 0; bj < 2; ++bj)
#pragma unroll
            for (int n = 0; n < 2; ++n) gv[bj][n] = *(const f32x4*)(gate + rt * 12288 + col0 + bj * HALF + n * 16);
#pragma unroll
        for (int ai = 0; ai < 2; ++ai)
#pragma unroll
            for (int m = 0; m < 4; ++m) { float* hp = H + (size_t)(row0 + ai * HALF + m * 16) * 2048 + col0;
#pragma unroll
                for (int bj = 0; bj < 2; ++bj)
#pragma unroll
                    for (int n = 0; n < 2; ++n) { float* p = hp + bj * HALF + n * 16; *(f32x4*)p = *(const f32x4*)p + gv[bj][n] * acc[ai][bj][m][n]; } }
    }
};
struct EpiSwiglu {
    static constexpr bool PERM = true, AFTER_DRAIN = false;
    bf16_t* ACT;
    __device__ __forceinline__ void operator()(const f32x4 (&acc)[2][2][4][2], const Unit& u, int wr, int wc, int fr, int fq) const {
        const int row0 = u.pm * BM + wr * 64 + fr, col0 = u.pn * HALF + wc * 32 + 8 * fq;
#pragma unroll
        for (int ai = 0; ai < 2; ++ai)
#pragma unroll
            for (int m = 0; m < 4; ++m) { float v[8];
#pragma unroll
                for (int n = 0; n < 2; ++n)
#pragma unroll
                    for (int e = 0; e < 4; ++e) { const float g = acc[ai][0][m][n][e], up = acc[ai][1][m][n][e]; v[4 * n + e] = g / (1.0f + __expf(-g)) * up; }
                u32x4 w; w.x = cvt_pk_bf16(v[0], v[1]); w.y = cvt_pk_bf16(v[2], v[3]); w.z = cvt_pk_bf16(v[4], v[5]); w.w = cvt_pk_bf16(v[6], v[7]);
                *(u32x4*)(ACT + (size_t)(row0 + ai * HALF + m * 16) * mk::FF + col0) = w; }
    }
};
struct BranchOrder {
    StaticOrder so;
    __device__ void init(int G, int c) { so.init(mk::M, 2048, G, c); }
    __device__ bool next(int i, Unit& u) const { const int it = i / 3, n = i - 3 * it; if (!so.next(it, u)) return false; u.pm += 36 * n; u.pn += 8 * n; return true; }
    __device__ __forceinline__ void a_ready(const Unit&) const {}
    __device__ __forceinline__ void done(const Unit&) const {}
};
}

namespace att {
using namespace mk;
constexpr int DH = 128, NW = 8, QBLK = 32, KVBLK = 64;
constexpr float SCALE = 0.088388347648318440f;
constexpr float THR = 8.f;
constexpr int LDQ = NP, LDK = NP, LDO = D;
constexpr int SHM_V = KVBLK * DH * 2, SHM_K = KVBLK * DH * 2, SHM_ATTN = 2 * SHM_V + 2 * SHM_K + NW * 64 * 4;
#define KSWZ(row, colB) ((row) * 256 + ((colB) ^ (((row) & 7) << 4)))
#define SBAR() __builtin_amdgcn_sched_barrier(0)
__device__ __forceinline__ unsigned cvtpk(float lo, float hi) { unsigned r; asm volatile("v_cvt_pk_bf16_f32 %0, %1, %2" : "=v"(r) : "v"(lo), "v"(hi)); return r; }
__device__ __forceinline__ void partialSM(f32x16& p0, f32x16& p1, float& m_reg, float& mn, float& alpha) {
  constexpr float C = SCALE * 1.4426950408889634f;
  float pmax = p0[0];
#pragma unroll
  for (int r = 1; r < 16; ++r) pmax = fmaxf(pmax, p0[r]);
#pragma unroll
  for (int r = 0; r < 16; ++r) pmax = fmaxf(pmax, p1[r]);
  { auto rr = __builtin_amdgcn_permlane32_swap(__float_as_uint(pmax), __float_as_uint(pmax), false, false);
    pmax = fmaxf(__uint_as_float(rr[0]), __uint_as_float(rr[1])); }
  if (__builtin_expect(__all(pmax - m_reg <= THR / SCALE), 1)) { mn = m_reg; alpha = 1.f; }
  else { mn = fmaxf(m_reg, pmax); alpha = __builtin_amdgcn_exp2f((m_reg - mn) * C); m_reg = mn; }
  float mnC = -mn * C;
#pragma unroll
  for (int r = 0; r < 16; ++r) p0[r] = fmaf(p0[r], C, mnC);
#pragma unroll
  for (int r = 0; r < 16; ++r) p1[r] = fmaf(p1[r], C, mnC);
#pragma unroll
  for (int r = 0; r < 16; ++r) p0[r] = __builtin_amdgcn_exp2f(p0[r]);
}
__device__ __forceinline__ void finishSM(f32x16& p0, f32x16& p1, float alpha, float& l_reg, bf16x8& pa0, bf16x8& pa1, bf16x8& pa2, bf16x8& pa3) {
#pragma unroll
  for (int r = 0; r < 16; ++r) p1[r] = __builtin_amdgcn_exp2f(p1[r]);
  float ps = 0;
#pragma unroll
  for (int r = 0; r < 16; ++r) ps += p0[r];
#pragma unroll
  for (int r = 0; r < 16; ++r) ps += p1[r];
  { auto rr = __builtin_amdgcn_permlane32_swap(__float_as_uint(ps), __float_as_uint(ps), false, false);
    ps = __uint_as_float(rr[0]) + __uint_as_float(rr[1]); }
  l_reg = l_reg * alpha + ps;
#define PK4(P, BASE, OUT) do { unsigned a0 = cvtpk(P[BASE + 0], P[BASE + 1]), a1 = cvtpk(P[BASE + 2], P[BASE + 3]);   \
    unsigned b0 = cvtpk(P[BASE + 4], P[BASE + 5]), b1 = cvtpk(P[BASE + 6], P[BASE + 7]);                              \
    auto r0 = __builtin_amdgcn_permlane32_swap(a0, b0, false, false); auto r1 = __builtin_amdgcn_permlane32_swap(a1, b1, false, false); \
    u32x4 w = {r0[0], r1[0], r0[1], r1[1]}; OUT = *reinterpret_cast<bf16x8*>(&w); } while (0)
  PK4(p0, 0, pa0); PK4(p0, 8, pa1); PK4(p1, 0, pa2); PK4(p1, 8, pa3);
#undef PK4
}
__device__ __forceinline__ void qkt(f32x16& p0, f32x16& p1, const bf16* Ks, const bf16x8* qr, int r32, int hi) {
  p0 = f32x16{}; p1 = f32x16{};
#pragma unroll
  for (int d0 = 0; d0 < 8; ++d0) { int cb = (d0 * 16 + hi * 8) * 2;
    bf16x8 b0 = *reinterpret_cast<const bf16x8*>((const char*)Ks + KSWZ(r32, cb));
    bf16x8 b1 = *reinterpret_cast<const bf16x8*>((const char*)Ks + KSWZ(32 + r32, cb));
    p0 = MFMA32(b0, qr[d0], p0);
    p1 = MFMA32(b1, qr[d0], p1); }
}
__device__ __forceinline__ int v_st(int k, int c) { const int kk = (k & ~0xC) | ((k & 4) << 1) | ((k & 8) >> 1); return ((kk >> 3) * 4 + (c >> 5)) * 512 + ((kk & 7) * 32 + (c & 31)) * 2; }
__device__ __forceinline__ int v_rd_base(int lane) { return ((lane & 3) << 3) | (((lane >> 2) & 3) << 6) | (((lane >> 4) & 1) << 5) | (((lane >> 5) & 1) << 8); }
constexpr int v_rd_off(int d0, int ks, int half) { return d0 * 512 + ks * 4096 + half * 2048; }
template <int OFF> __device__ __forceinline__ s16x4 tr_read(int vb) {
  s16x4 r; asm volatile("ds_read_b64_tr_b16 %0, %1 offset:%2" : "=&v"(r) : "v"(vb), "i"(OFF) : "memory"); return r;
}
template <int D0> __device__ __forceinline__ void pv_one(f32x16& od, int vb, bf16x8 pa0, bf16x8 pa1, bf16x8 pa2, bf16x8 pa3) {
  const s16x4 l0 = tr_read<v_rd_off(D0, 0, 0)>(vb), h0 = tr_read<v_rd_off(D0, 0, 1)>(vb), l1 = tr_read<v_rd_off(D0, 1, 0)>(vb), h1 = tr_read<v_rd_off(D0, 1, 1)>(vb);
  const s16x4 l2 = tr_read<v_rd_off(D0, 2, 0)>(vb), h2 = tr_read<v_rd_off(D0, 2, 1)>(vb), l3 = tr_read<v_rd_off(D0, 3, 0)>(vb), h3 = tr_read<v_rd_off(D0, 3, 1)>(vb);
  asm volatile("s_waitcnt lgkmcnt(0)" ::: "memory"); SBAR();
#define PK(L, H) (bf16x8){L[0], L[1], L[2], L[3], H[0], H[1], H[2], H[3]}
  od = MFMA32(pa0, PK(l0, h0), od);
  od = MFMA32(pa1, PK(l1, h1), od);
  od = MFMA32(pa2, PK(l2, h2), od);
  od = MFMA32(pa3, PK(l3, h3), od);
#undef PK
}
__device__ __forceinline__ void pv_d0(f32x16* o, int vb, bf16x8 pa0, bf16x8 pa1, bf16x8 pa2, bf16x8 pa3) {
  pv_one<0>(o[0], vb, pa0, pa1, pa2, pa3); pv_one<1>(o[1], vb, pa0, pa1, pa2, pa3); pv_one<2>(o[2], vb, pa0, pa1, pa2, pa3); pv_one<3>(o[3], vb, pa0, pa1, pa2, pa3);
}
__device__ __forceinline__ void attn_dense_body(const bf16* __restrict__ Qb, const bf16* __restrict__ Kh, const bf16* __restrict__ Vh, bf16* __restrict__ Ob, int seq, char* lds) {
  int tid_ = threadIdx.x; asm volatile("" : "+v"(tid_));
  const int tid = tid_, wid = tid >> 6, lane = tid & 63, r32 = lane & 31, hi = lane >> 5;
  bf16* V_lds = (bf16*)lds; bf16* K_lds = (bf16*)(lds + 2 * SHM_V);
  float* ws = (float*)(lds + 2 * SHM_V + 2 * SHM_K) + wid * 64; float* li_l = ws; float* al_l = ws + 32;
  float m_reg = -1e30f, l_reg = 0; f32x16 o[4] = {}; bf16x8 qr[8];
  const bf16* Qw = Qb + (long)(wid * QBLK + r32) * LDQ + hi * 8;
#pragma unroll
  for (int d0 = 0; d0 < 8; ++d0) qr[d0] = *reinterpret_cast<const bf16x8*>(Qw + d0 * 16);
  const int sr = tid >> 4, sc = (tid & 15) * 8, vst0 = v_st(sr, sc), vst1 = v_st(32 + sr, sc);
  const int vb0 = (int)(uintptr_t)V_lds + v_rd_base(lane);
  struct { bf16x8 vs0, vs1, ks0, ks1; } sr_[2];
  const unsigned go0 = (unsigned)(sr * LDK + sc), go1 = (unsigned)((32 + sr) * LDK + sc);
#define SLOAD(i, k0) do { const bf16* vb_ = Vh + (long)(k0) * LDK; const bf16* kb_ = Kh + (long)(k0) * LDK; \
    sr_[i].vs0 = *reinterpret_cast<const bf16x8*>(vb_ + go0); sr_[i].vs1 = *reinterpret_cast<const bf16x8*>(vb_ + go1); \
    sr_[i].ks0 = *reinterpret_cast<const bf16x8*>(kb_ + go0); sr_[i].ks1 = *reinterpret_cast<const bf16x8*>(kb_ + go1); } while (0)
#define SWRITE(b, i) do { *(bf16x8*)((char*)V_lds + (b) * SHM_V + vst0) = sr_[i].vs0;          \
    *(bf16x8*)((char*)V_lds + (b) * SHM_V + vst1) = sr_[i].vs1; int kc = sc * 2;               \
    *(bf16x8*)((char*)K_lds + (b) * SHM_K + KSWZ(sr, kc)) = sr_[i].ks0;                       \
    *(bf16x8*)((char*)K_lds + (b) * SHM_K + KSWZ(32 + sr, kc)) = sr_[i].ks1; } while (0)
#define SWAIT() asm volatile("s_waitcnt vmcnt(4)" ::: "memory")
#define RESC(a) do { if (__any((a) < 1.f)) { if (hi == 0) al_l[r32] = (a); asm volatile("s_waitcnt lgkmcnt(0)" ::: "memory"); \
    _Pragma("unroll") for (int d = 0; d < 4; ++d) _Pragma("unroll") for (int r = 0; r < 16; ++r) o[d][r] *= al_l[crow(r, hi)]; } } while (0)
  f32x16 pA0, pA1, pB0, pB1; float mnA, mnB, alA, alB; bf16x8 pa0, pa1, pa2, pa3; const int NT = seq / KVBLK;
  constexpr int SE = 0, SO = 1;
  SLOAD(SE, 0); asm volatile("s_waitcnt vmcnt(0)" ::: "memory"); SWRITE(0, SE); __syncthreads();
  qkt(pA0, pA1, K_lds, qr, r32, hi); partialSM(pA0, pA1, m_reg, mnA, alA);
  SLOAD(SO, KVBLK); if (2 < NT) SLOAD(SE, 2 * KVBLK);
  SWAIT(); SWRITE(1, SO); __syncthreads();
  for (int j = 1; j + 1 < NT; j += 2) {
    SBAR(); qkt(pB0, pB1, (bf16*)((char*)K_lds + SHM_K), qr, r32, hi);
    finishSM(pA0, pA1, alA, l_reg, pa0, pa1, pa2, pa3); SBAR();
    SLOAD(SO, (j + 2) * KVBLK); SBAR();
    pv_d0(o, vb0, pa0, pa1, pa2, pa3); partialSM(pB0, pB1, m_reg, mnB, alB);
    __syncthreads(); SWAIT(); SWRITE(0, SE);
    RESC(alB); __syncthreads();
    SBAR(); qkt(pA0, pA1, K_lds, qr, r32, hi);
    finishSM(pB0, pB1, alB, l_reg, pa0, pa1, pa2, pa3); SBAR();
    if (j + 3 < NT) SLOAD(SE, (j + 3) * KVBLK); SBAR();
    pv_d0(o, vb0 + (int)SHM_V, pa0, pa1, pa2, pa3); partialSM(pA0, pA1, m_reg, mnA, alA);
    __syncthreads(); SWAIT(); SWRITE(1, SO);
    RESC(alA); __syncthreads();
  }
  SBAR(); qkt(pB0, pB1, (bf16*)((char*)K_lds + SHM_K), qr, r32, hi);
  finishSM(pA0, pA1, alA, l_reg, pa0, pa1, pa2, pa3); SBAR();
  pv_d0(o, vb0, pa0, pa1, pa2, pa3); partialSM(pB0, pB1, m_reg, mnB, alB);
  __syncthreads(); RESC(alB);
  finishSM(pB0, pB1, alB, l_reg, pa0, pa1, pa2, pa3); SBAR();
  pv_d0(o, vb0 + (int)SHM_V, pa0, pa1, pa2, pa3);
  if (hi == 0) li_l[r32] = l_reg; asm volatile("s_waitcnt lgkmcnt(0)" ::: "memory");
  float rli[16];
#pragma unroll
  for (int r = 0; r < 16; ++r) rli[r] = __builtin_amdgcn_rcpf(li_l[crow(r, hi)]);
  bf16* Ow = Ob + (long)(wid * QBLK) * LDO; const unsigned oo = (unsigned)(4 * hi * LDO + r32);
#pragma unroll
  for (int r = 0; r < 16; ++r) { const unsigned off = oo + (unsigned)(((r & 3) + 8 * (r >> 2)) * LDO);
#pragma unroll
    for (int d0 = 0; d0 < 4; ++d0) Ow[off + d0 * 32] = f2bf(o[d0][r] * rli[r]); }
#undef SLOAD
#undef SWRITE
#undef SWAIT
#undef RESC
}
}

namespace mk {
#define LDS_WAIT() asm volatile("s_waitcnt lgkmcnt(0)" ::: "memory")

__device__ __forceinline__ void transpose_item(const float* W, size_t ldw, bf16* WT, size_t Kd, int k0, int nsrc0, int ndst0, LAS float* scr, int lane) {
#pragma unroll 8
    for (int i = 0; i < 32; ++i) { const int kk = 2 * i + (lane >> 5); scr[kk * 33 + (lane & 31)] = W[(size_t)(k0 + kk) * ldw + nsrc0 + (lane & 31)]; }
    LDS_WAIT(); asm volatile("" ::: "memory");
    const int c = lane & 7;
#pragma unroll
    for (int j = 0; j < 4; ++j) { const int n = (lane >> 3) + 8 * j; const LAS float* s = scr + (8 * c) * 33 + n;
        u32x4 o; o.x = pk2(s[0 * 33], s[1 * 33]); o.y = pk2(s[2 * 33], s[3 * 33]); o.z = pk2(s[4 * 33], s[5 * 33]); o.w = pk2(s[6 * 33], s[7 * 33]);
        *(u32x4*)(WT + (size_t)(ndst0 + n) * Kd + k0 + 8 * c) = o; }
    LDS_WAIT(); asm volatile("" ::: "memory");
}
constexpr int IT_WIN = 32 * 609, IT_WBR = 3 * 32 * 64, IT_WOUT = 32 * 64, IT_WF1 = 32 * 352, IT_WF2 = 88 * 64, IT_LRU = 512;
constexpr int IT_LAYER = IT_WIN + IT_WBR + IT_WOUT + IT_WF1 + IT_WF2 + IT_LRU;

__device__ __forceinline__ void phase_prologue(Frame& F) {
    refresh(F);
    const int gw = F.vcu * NWAVES + F.wave, NGW = F.G * NWAVES, lane = F.lane;
    LAS float* scr = (LAS float*)(F.lds + F.wave * 16384);
    unsigned char* ws = F.ws;
    for (int it = gw; it < DEPTH * IT_LAYER; it += NGW) {
        const int l = it / IT_LAYER; int r = it - l * IT_LAYER;
        if (r < IT_WIN) { const int kb = r / 609, nb = r - kb * 609, ns = 32 * nb; const int nd = ns < 6144 ? ns : (ns < 6176 ? 19456 + (ns - 6144) : ns - 32);
            transpose_item(F.ka->in[I_WIN] + (size_t)l * D * NIN, NIN, (bf16*)(ws + WS_WIN + l * WIN_L), D, 64 * kb, ns, nd, scr, lane); continue; }
        r -= IT_WIN;
        if (r < IT_WBR) { const int n = r / 2048, rr = r - n * 2048, kb = rr >> 6, nb = rr & 63;
            transpose_item(F.ka->in[I_WBR] + ((size_t)l * 3 + n) * D * D, D, (bf16*)(ws + WS_WBR + l * WBR_L), D, 64 * kb, 32 * nb, n * 2048 + 32 * nb, scr, lane); continue; }
        r -= IT_WBR;
        if (r < IT_WOUT) { const int kb = r >> 6, nb = r & 63;
            transpose_item(F.ka->in[I_WOUT] + (size_t)l * D * D, D, (bf16*)(ws + WS_WOUT + l * WOUT_L), D, 64 * kb, 32 * nb, 32 * nb, scr, lane); continue; }
        r -= IT_WOUT;
        if (r < IT_WF1) { const int kb = r / 352, nb = r - kb * 352, ns = 32 * nb; const int up = ns >= FF ? 1 : 0, j = ns - up * FF; const int nd = (j >> 7) * 256 + up * 128 + (j & 127);
            transpose_item(F.ka->in[I_WF1] + (size_t)l * D * NF1, NF1, (bf16*)(ws + WS_WF1 + l * WF1_L), D, 64 * kb, ns, nd, scr, lane); continue; }
        r -= IT_WF1;
        if (r < IT_WF2) { const int kb = r >> 6, nb = r & 63;
            transpose_item(F.ka->in[I_WF2] + (size_t)l * FF * D, D, (bf16*)(ws + WS_WF2 + l * WF2_L), FF, 64 * kb, 32 * nb, 32 * nb, scr, lane); continue; }
        r -= IT_WF2;
        {
            const int sub = r & 7, mat = r >> 3, gate = mat & 1, n = (mat >> 1) & 15, dir = mat >> 5, kb = sub >> 2, nb = sub & 3;
            const float* W = (gate ? F.ka->in[I_LWI] : F.ka->in[I_LWA]) + (((size_t)l * 2 + dir) * 16 + n) * 128 * 128;
            transpose_item(W, 128, ((bf16*)(F.ws + WS_WL)) + ((size_t)l * 16 + n) * 512 * 128, 128, 64 * kb, 32 * nb, (dir * 2 + gate) * 128 + 32 * nb, scr, lane); }
    }
    for (int i = gw * 64 + lane; i < DEPTH * 224 * 256; i += NGW * 64) { const int l = i / (224 * 256), r = i - l * 224 * 256;
        *(u32x4*)((bf16*)(ws + WS_WIN + l * WIN_L) + (size_t)NIN * D + (size_t)r * 8) = (u32x4){0u, 0u, 0u, 0u}; }
    for (int row = gw; row < M; row += NGW) { const int b = row / TT, t = row - b * TT;
        const f32x4* src = (const f32x4*)(t < TL ? F.ka->in[I_X] + ((size_t)b * TL + t) * D : F.ka->in[I_CTX] + ((size_t)b * LC + (t - TL)) * D);
        f32x4* dst = (f32x4*)(((float*)(F.ws + WS_H)) + (size_t)row * D);
#pragma unroll
        for (int j = 0; j < 8; ++j) dst[lane + 64 * j] = src[lane + 64 * j]; }
    for (int i = gw * 64 + lane; i < TL * 64; i += NGW * 64) { const int t = i >> 6, p = i & 63; const int rr = t >> 6, cc = t & 63;
        const float inv = exp2f(-(float)(p & 31) * (13.287712379549449f / 32.0f)); const float ang = (float)(p < 32 ? rr : cc) * inv;
        ((float*)(F.ws + WS_ROPE))[i] = cosf(ang); ((float*)(F.ws + WS_ROPE))[TL * 64 + i] = sinf(ang); }
    __syncthreads();
    LAS float* SC = (LAS float*)F.lds; LAS float* RED = (LAS float*)(F.lds + 40960);
    for (int i = F.tid; i < 5 * D; i += NTHR) { const int rt = i / D, k = i - rt * D; const float c = rt < 4 ? F.ka->in[I_C][rt * D + k] : F.ka->in[I_CCTX][k]; SC[i] = siluf_(c); }
    __syncthreads();
    for (int u = F.vcu; u < DEPTH * 192; u += F.G) { const int l = u / 192, cb = u - l * 192; const int cg = F.tid & 15, ks = F.tid >> 4;
        const float* wp = F.ka->in[I_WMOD] + ((size_t)l * D + ks * 64) * (6 * D) + cb * 64 + cg * 4;
        f32x4 a0 = {0, 0, 0, 0}, a1 = a0, a2 = a0, a3 = a0, a4 = a0;
#pragma unroll 8
        for (int k = 0; k < 64; ++k) { const f32x4 w = *(const f32x4*)(wp + (size_t)k * (6 * D)); const int kk = ks * 64 + k;
            a0 += SC[kk] * w; a1 += SC[D + kk] * w; a2 += SC[2 * D + kk] * w; a3 += SC[3 * D + kk] * w; a4 += SC[4 * D + kk] * w; }
        *(LAS f32x4*)(RED + (ks * 5 + 0) * 64 + cg * 4) = a0; *(LAS f32x4*)(RED + (ks * 5 + 1) * 64 + cg * 4) = a1; *(LAS f32x4*)(RED + (ks * 5 + 2) * 64 + cg * 4) = a2;
        *(LAS f32x4*)(RED + (ks * 5 + 3) * 64 + cg * 4) = a3; *(LAS f32x4*)(RED + (ks * 5 + 4) * 64 + cg * 4) = a4;
        __syncthreads();
        if (F.tid < 320) { const int rt = F.tid >> 6, c = F.tid & 63; float s = F.ka->in[I_BMOD][(size_t)l * 6 * D + cb * 64 + c];
#pragma unroll 8
            for (int k2 = 0; k2 < 32; ++k2) s += RED[(k2 * 5 + rt) * 64 + c];
            ((float*)(F.ws + WS_MOD))[((size_t)l * 5 + rt) * (6 * D) + cb * 64 + c] = s; }
        __syncthreads();
    }
}

__device__ __forceinline__ void phase_norm(Frame& F, int l, const float* gain, int i_shift, int i_scale) {
    refresh(F);
    const int gw = F.vcu * NWAVES + F.wave, NGW = F.G * NWAVES, lane = F.lane;
    for (int row = gw; row < M; row += NGW) { const int b = row / TT, t = row - b * TT, rt = t < TL ? b : 4;
        const f32x4* hp = (const f32x4*)(((float*)(F.ws + WS_H)) + (size_t)row * D); f32x4 v[8]; float ss = 0.f;
#pragma unroll
        for (int j = 0; j < 8; ++j) { v[j] = hp[lane + 64 * j]; ss += (v[j].x * v[j].x + v[j].y * v[j].y) + (v[j].z * v[j].z + v[j].w * v[j].w); }
        const float rstd = 1.0f / sqrtf(wave_sum(ss) * (1.0f / D) + EPS);
        const float* mod = ((float*)(F.ws + WS_MOD)) + ((size_t)l * 5 + rt) * (6 * D);
        u32x2* up = (u32x2*)(((bf16*)(F.ws + WS_U)) + (size_t)row * D);
#pragma unroll
        for (int j = 0; j < 8; ++j) { const int c4 = lane + 64 * j; const f32x4 g = ((const f32x4*)gain)[c4], sc = ((const f32x4*)(mod + i_scale * D))[c4], sh = ((const f32x4*)(mod + i_shift * D))[c4];
            const f32x4 o = (v[j] * rstd * g) * (sc + 1.0f) + sh; u32x2 w; w.x = pk2(o.x, o.y); w.y = pk2(o.z, o.w); up[c4] = w; } }
}
__device__ __forceinline__ void phase_final(Frame& F) {
    refresh(F);
    const int gw = F.vcu * NWAVES + F.wave, NGW = F.G * NWAVES, lane = F.lane; const float* gain = F.ka->in[I_FNG];
    for (int idx = gw; idx < NB * TL; idx += NGW) { const int b = idx / TL, t = idx - b * TL; const size_t row = (size_t)b * TT + t;
        const f32x4* hp = (const f32x4*)(((float*)(F.ws + WS_H)) + row * D); f32x4 v[8]; float ss = 0.f;
#pragma unroll
        for (int j = 0; j < 8; ++j) { v[j] = hp[lane + 64 * j]; ss += (v[j].x * v[j].x + v[j].y * v[j].y) + (v[j].z * v[j].z + v[j].w * v[j].w); }
        const float rstd = 1.0f / sqrtf(wave_sum(ss) * (1.0f / D) + EPS);
        f32x4* op = (f32x4*)(F.ka->out + (size_t)idx * D);
#pragma unroll
        for (int j = 0; j < 8; ++j) { const int c4 = lane + 64 * j; op[c4] = v[j] * rstd * ((const f32x4*)gain)[c4]; } }
}

__device__ __forceinline__ void prep_attn(Frame& F, int l) {
    refresh(F);
    const int gw = F.vcu * NWAVES + F.wave, NGW = F.G * NWAVES, lane = F.lane;
    const float gq0 = F.ka->in[I_QNG][l * 128 + 2 * lane], gq1 = F.ka->in[I_QNG][l * 128 + 2 * lane + 1], gk0 = F.ka->in[I_KNG][l * 128 + 2 * lane], gk1 = F.ka->in[I_KNG][l * 128 + 2 * lane + 1];
    for (int row = gw; row < M; row += NGW) { const int t = row % TT; const bool lat = t < TL;
        unsigned* base = (unsigned*)(((bf16*)(F.ws + WS_PROJ)) + (size_t)row * NP + C_AQ) + lane;
        float cs = 1.f, sn = 0.f; if (lat) { cs = ((float*)(F.ws + WS_ROPE))[t * 64 + lane]; sn = ((float*)(F.ws + WS_ROPE))[TL * 64 + t * 64 + lane]; }
        unsigned x[20];
#pragma unroll
        for (int h = 0; h < 20; ++h) x[h] = base[h * 64];
#pragma unroll
        for (int h = 0; h < 20; ++h) { const float x1 = bflo(x[h]), x2 = bfhi(x[h]); const float ss = wave_sum(x1 * x1 + x2 * x2);
            const float rstd = 1.0f / sqrtf(ss * (1.0f / 128.0f) + EPS); const float y1 = x1 * rstd * (h < 16 ? gq0 : gk0), y2 = x2 * rstd * (h < 16 ? gq1 : gk1);
            base[h * 64] = pk2(y1 * cs - y2 * sn, y1 * sn + y2 * cs); } }
}
__device__ __forceinline__ void prep_gla(Frame& F, int l) {
    refresh(F);
    LAS float* DECs = (LAS float*)F.lds;
    const int tid = F.tid, dir = tid >> 8, cp = tid & 255;
    for (int u = F.vcu; u < 288; u += F.G) { const int b = u / 72, rem = u - b * 72, c = rem >> 1, half = rem & 1; const size_t R0 = (size_t)b * TT + 64 * c;
        __syncthreads();
        *(LAS f32x4*)(DECs + tid * 4) = *(const f32x4*)(((float*)(F.ws + WS_DEC)) + R0 * 32 + tid * 4);
        __syncthreads();
        const int k0 = half * 512 + 2 * cp;
        f32x2 wv[16];
#pragma unroll
        for (int r = 0; r < 16; ++r) wv[r] = *(const f32x2*)(F.ka->in[I_GWD] + (((size_t)l * 2 + dir) * 16 + r) * 1024 + k0);
        const f32x2 bd = *(const f32x2*)(F.ka->in[I_GBD] + ((size_t)l * 2 + dir) * 1024 + k0);
        f32x2 run = {0.f, 0.f};
#define GLA_LA(t_, la_) do { f32x2 z = bd; _Pragma("unroll") for (int r = 0; r < 16; ++r) z += DECs[(t_) * 32 + dir * 16 + r] * wv[r]; \
            la_.x = (fminf(z.x, 0.f) - __logf(1.0f + __expf(-fabsf(z.x)))) * 0.0625f; la_.y = (fminf(z.y, 0.f) - __logf(1.0f + __expf(-fabsf(z.y)))) * 0.0625f; } while (0)
#pragma unroll 4
        for (int i = 0; i < 64; ++i) { const int t = dir ? 63 - i : i; f32x2 la; GLA_LA(t, la); run += la; }
        const f32x2 tot = run;
        { f32x2 dl; dl.x = __expf(tot.x); dl.y = __expf(tot.y); *(f32x2*)(((float*)(F.ws + WS_DL)) + ((size_t)dir * 144 + b * 36 + c) * 1024 + k0) = dl; }
        bf16* QDp = ((bf16*)(F.ws + WS_QD)) + (size_t)dir * M * 1024; bf16* KNp = ((bf16*)(F.ws + WS_QD)) + (size_t)(2 + dir) * M * 1024; bf16* KDp = ((bf16*)(F.ws + WS_QD)) + (size_t)(4 + dir) * M * 1024;
        run = (f32x2){0.f, 0.f};
#pragma unroll 4
        for (int i = 0; i < 64; ++i) { const int t = dir ? 63 - i : i; const size_t row = R0 + t; f32x2 la; GLA_LA(t, la); run += la;
            const unsigned q2 = *(const unsigned*)(((bf16*)(F.ws + WS_PROJ)) + row * NP + C_GQ + k0), k2 = *(const unsigned*)(((bf16*)(F.ws + WS_PROJ)) + row * NP + C_GK + k0);
            const float e0 = __expf(run.x), e1 = __expf(run.y), n0 = __expf(-run.x), n1 = __expf(-run.y), d0 = __expf(tot.x - run.x), d1 = __expf(tot.y - run.y);
            const float q0 = bflo(q2) * 0.0625f, q1 = bfhi(q2) * 0.0625f, kk0 = bflo(k2), kk1 = bfhi(k2);
            *(unsigned*)(QDp + row * 1024 + k0) = pk2(q0 * e0, q1 * e1);
            *(unsigned*)(KNp + row * 1024 + k0) = pk2(kk0 * n0, kk1 * n1);
            *(unsigned*)(KDp + row * 1024 + k0) = pk2(kk0 * d0, kk1 * d1); }
#undef GLA_LA
    }
}
__device__ __forceinline__ void prep_lru(Frame& F, int l) {
    refresh(F);
    constexpr int XBS = 272, XFS = 528, O_XF = 64 * XBS;
    LAS unsigned char* lds = F.lds;
    const int tid = F.tid, lane = F.lane, wv = F.wave, i16 = lane & 15, g4 = lane >> 4;
    const int n = F.vcu & 15, slot = F.vcu >> 4, nslot = F.G >> 4;
    bf16x8 Bf[4][4];
#pragma unroll
    for (int gi = 0; gi < 4; ++gi)
#pragma unroll
        for (int ks = 0; ks < 4; ++ks) Bf[gi][ks] = *(const bf16x8*)(((bf16*)(F.ws + WS_WL)) + (((size_t)l * 16 + n) * 512 + gi * 128 + 16 * wv + i16) * 128 + 32 * ks + 8 * g4);
    const int C = 128 * n + 16 * wv + i16;
    float ba[2], bi[2], sp8[2];
#pragma unroll
    for (int d = 0; d < 2; ++d) { ba[d] = F.ka->in[I_LBA][((size_t)l * 2 + d) * D + C]; bi[d] = F.ka->in[I_LBI][((size_t)l * 2 + d) * D + C];
        const float lam = F.ka->in[I_LAM][((size_t)l * 2 + d) * D + C]; sp8[d] = 8.0f * (fmaxf(-lam, 0.f) + __logf(1.0f + __expf(-fabsf(lam)))); }
    const int cgp = tid & 15, tk = tid >> 4; const int cch = 128 * n + 8 * cgp;
    for (int tt = slot; tt < M / 64; tt += nslot) { const int R0 = 64 * tt, b = R0 / TT, tq = R0 - b * TT;
        const int seq_lo = tq < TL ? b * TT : b * TT + TL, seq_hi = tq < TL ? b * TT + TL : (b + 1) * TT;
        f32x4 cw[4][2], cbv[2];
#pragma unroll
        for (int j = 0; j < 4; ++j) { cw[j][0] = *(const f32x4*)(F.ka->in[I_CW] + ((size_t)l * 4 + j) * D + cch); cw[j][1] = *(const f32x4*)(F.ka->in[I_CW] + ((size_t)l * 4 + j) * D + cch + 4); }
        cbv[0] = *(const f32x4*)(F.ka->in[I_CB] + (size_t)l * D + cch); cbv[1] = *(const f32x4*)(F.ka->in[I_CB] + (size_t)l * D + cch + 4);
#pragma unroll
        for (int q = 0; q < 2; ++q) { const int tok = tk + 32 * q, row = R0 + tok; f32x4 a0 = cbv[0], a1 = cbv[1];
#pragma unroll
            for (int j = 0; j < 4; ++j) { const int rr = row + j - 2; u32x4 xv = {0u, 0u, 0u, 0u};
                if (rr >= seq_lo && rr < seq_hi) xv = *(const u32x4*)(((bf16*)(F.ws + WS_PROJ)) + (size_t)rr * NP + C_LX + cch);
                f32x4 x0 = {bflo(xv.x), bfhi(xv.x), bflo(xv.y), bfhi(xv.y)}, x1 = {bflo(xv.z), bfhi(xv.z), bflo(xv.w), bfhi(xv.w)};
                a0 += cw[j][0] * x0; a1 += cw[j][1] * x1; }
            *(LAS f32x4*)(lds + O_XF + tok * XFS + cgp * 32) = a0; *(LAS f32x4*)(lds + O_XF + tok * XFS + cgp * 32 + 16) = a1;
            u32x4 w; w.x = pk2(a0.x, a0.y); w.y = pk2(a0.z, a0.w); w.z = pk2(a1.x, a1.y); w.w = pk2(a1.z, a1.w);
            *(LAS u32x4*)(lds + tok * XBS + cgp * 16) = w; }
        __syncthreads();
        f32x4 acc[4][4];
#pragma unroll
        for (int tb = 0; tb < 4; ++tb)
#pragma unroll
            for (int gi = 0; gi < 4; ++gi) acc[tb][gi] = (f32x4){0.f, 0.f, 0.f, 0.f};
#pragma unroll
        for (int tb = 0; tb < 4; ++tb)
#pragma unroll
            for (int ks = 0; ks < 4; ++ks) { const bf16x8 a = *(const LAS bf16x8*)(lds + (16 * tb + i16) * XBS + (32 * ks + 8 * g4) * 2);
#pragma unroll
                for (int gi = 0; gi < 4; ++gi) acc[tb][gi] = MFMA16(a, Bf[gi][ks], acc[tb][gi]); }
        const int first0 = b * TT + TL, first1 = b * TT + TL + LC - 1;
#pragma unroll
        for (int tb = 0; tb < 4; ++tb)
#pragma unroll
            for (int rg = 0; rg < 4; ++rg) { const int tok = 16 * tb + 4 * g4 + rg, row = R0 + tok; const float x = *(const LAS float*)(lds + O_XF + tok * XFS + (16 * wv + i16) * 4);
#pragma unroll
                for (int d = 0; d < 2; ++d) { const float r = sigmoidf_(acc[tb][2 * d][rg] + ba[d]), ig = sigmoidf_(acc[tb][2 * d + 1][rg] + bi[d]);
                    const float la = -r * sp8[d], a = __expf(la); float mult = sqrtf(fmaxf(1.0f - a * a, 0.f)); if (row == (d ? first1 : first0)) mult = 1.0f;
                    ((bf16*)(F.ws + WS_LA))[((size_t)d * M + row) * D + C] = f2bf(la); ((bf16*)(F.ws + WS_LA))[((size_t)(2 + d) * M + row) * D + C] = f2bf(mult * ig * x); } }
        __syncthreads();
    }
}

__device__ __forceinline__ void gla_unit(Frame& F, int unit) {
    refresh(F);
    constexpr int QS = 528, KS = 576, AS = 144;
    constexpr int O_QD = 0, O_KN = 33792, O_KD = 67584, O_V = 104448, O_ATT = 141312, O_DL = 150528;
    LAS unsigned char* lds = F.lds;
    const int tid = F.tid, lane = F.lane, wv = F.wave, r32 = lane & 31, hh = lane >> 5, i16 = lane & 15, g4 = lane >> 4;
    const int b = unit >> 4, hd = (unit >> 2) & 3, dir = (unit >> 1) & 1, half = unit & 1;
    const bf16* gQD = ((bf16*)(F.ws + WS_QD)) + (size_t)dir * M * 1024 + hd * 256; const bf16* gKN = ((bf16*)(F.ws + WS_QD)) + (size_t)(2 + dir) * M * 1024 + hd * 256; const bf16* gKD = ((bf16*)(F.ws + WS_QD)) + (size_t)(4 + dir) * M * 1024 + hd * 256;
    const bf16* gV = ((bf16*)(F.ws + WS_PROJ)) + C_GV + hd * 512 + half * 256;
    bf16* gO = (dir ? ((bf16*)(F.ws + WS_OB)) : ((bf16*)(F.ws + WS_OF))) + hd * 512 + half * 256 + 32 * wv;
    const float* gDL = ((float*)(F.ws + WS_DL)) + ((size_t)dir * 144 + b * 36) * 1024 + hd * 256;
    f32x16 S[8];
#pragma unroll
    for (int i = 0; i < 8; ++i) S[i] = f32x16{};
    for (int s = 0; s < 36; ++s) {
        const int c = dir ? 35 - s : (s < 4 ? 32 + s : s - 4); const size_t R0 = (size_t)b * TT + 64 * c;
        { const unsigned vq = (unsigned)((tid >> 5) * 1024 + 8 * (tid & 31)), vv = (unsigned)((tid >> 5) * NP + 8 * (tid & 31));
          LAS unsigned char* lq = lds + (tid >> 5) * QS + 16 * (tid & 31); LAS unsigned char* lk = lds + (tid >> 5) * KS + 16 * (tid & 31);
#pragma unroll
          for (int i = 0; i < 4; ++i) {
            const bf16* bq = gQD + (R0 + 16 * i) * 1024; const bf16* bn = gKN + (R0 + 16 * i) * 1024; const bf16* bk = gKD + (R0 + 16 * i) * 1024; const bf16* bv = gV + (R0 + 16 * i) * NP;
            const u32x4 q = *(const u32x4*)(bq + vq), kn = *(const u32x4*)(bn + vq), kd = *(const u32x4*)(bk + vq), v = *(const u32x4*)(bv + vv);
            *(LAS u32x4*)(lq + O_QD + i * 16 * QS) = q; *(LAS u32x4*)(lq + O_KN + i * 16 * QS) = kn;
            *(LAS u32x4*)(lk + O_KD + i * 16 * KS) = kd; *(LAS u32x4*)(lk + O_V + i * 16 * KS) = v;
            if (i == 1) asm volatile("" ::: "memory"); } }
        if (tid < 64) *(LAS f32x4*)(lds + O_DL + tid * 16) = *(const f32x4*)(gDL + (size_t)c * 1024 + tid * 4);
        __syncthreads();
        { const int ib = wv >> 1, jb0 = 2 * (wv & 1); f32x4 at0 = {0.f, 0.f, 0.f, 0.f}, at1 = at0;
#pragma unroll
            for (int ks = 0; ks < 8; ++ks) { const int cb = (32 * ks + 8 * g4) * 2;
                const bf16x8 a = *(const LAS bf16x8*)(lds + O_QD + (16 * ib + i16) * QS + cb);
                const bf16x8 b0 = *(const LAS bf16x8*)(lds + O_KN + (16 * jb0 + i16) * QS + cb), b1 = *(const LAS bf16x8*)(lds + O_KN + (16 * (jb0 + 1) + i16) * QS + cb);
                at0 = MFMA16(a, b0, at0); at1 = MFMA16(a, b1, at1); }
#pragma unroll
            for (int rg = 0; rg < 4; ++rg) { const int i = 16 * ib + 4 * g4 + rg, j0 = 16 * jb0 + i16, j1 = j0 + 16;
                const bool k0 = dir ? (j0 >= i) : (j0 <= i), k1 = dir ? (j1 >= i) : (j1 <= i);
                *(LAS bf16*)(lds + O_ATT + i * AS + j0 * 2) = k0 ? f2bf(at0[rg]) : (bf16)0; *(LAS bf16*)(lds + O_ATT + i * AS + j1 * 2) = k1 ? f2bf(at1[rg]) : (bf16)0; } }
        f32x16 o0 = f32x16{}, o1 = f32x16{};
#pragma unroll
        for (int dkb = 0; dkb < 8; ++dkb)
#pragma unroll
            for (int st = 0; st < 2; ++st) { u32x4 pb; pb.x = pk2(S[dkb][8 * st + 0], S[dkb][8 * st + 1]); pb.y = pk2(S[dkb][8 * st + 2], S[dkb][8 * st + 3]);
                pb.z = pk2(S[dkb][8 * st + 4], S[dkb][8 * st + 5]); pb.w = pk2(S[dkb][8 * st + 6], S[dkb][8 * st + 7]); const bf16x8 bfr = __builtin_bit_cast(bf16x8, pb);
                const int dko = (32 * dkb + 16 * st + 4 * hh) * 2;
                const s16x4 l0 = *(const LAS s16x4*)(lds + O_QD + r32 * QS + dko), h0 = *(const LAS s16x4*)(lds + O_QD + r32 * QS + dko + 16);
                const s16x4 l1 = *(const LAS s16x4*)(lds + O_QD + (32 + r32) * QS + dko), h1 = *(const LAS s16x4*)(lds + O_QD + (32 + r32) * QS + dko + 16);
                o0 = MFMA32(cat8(l0, h0), bfr, o0); o1 = MFMA32(cat8(l1, h1), bfr, o1); }
        __syncthreads();
        bf16x8 Vf[4];
#pragma unroll
        for (int ks = 0; ks < 4; ++ks) { LAS unsigned char* p = lds + O_V + (16 * ks + 8 * hh + (i16 >> 2)) * KS + (32 * wv + 16 * (g4 & 1) + 4 * (i16 & 3)) * 2;
            Vf[ks] = cat8(vtr(p), vtr(p + 4 * KS)); }
#pragma unroll
        for (int ks = 0; ks < 4; ++ks) { const int cb = (16 * ks + 8 * hh) * 2;
            const bf16x8 a0 = *(const LAS bf16x8*)(lds + O_ATT + r32 * AS + cb), a1 = *(const LAS bf16x8*)(lds + O_ATT + (32 + r32) * AS + cb);
            o0 = MFMA32(a0, Vf[ks], o0); o1 = MFMA32(a1, Vf[ks], o1); }
        { bf16* ob = gO + R0 * D; const unsigned lo_ = (unsigned)(4 * hh * D + r32);
#pragma unroll
          for (int rg = 0; rg < 16; ++rg) { const unsigned off = lo_ + (unsigned)(((rg & 3) + 8 * (rg >> 2)) * D);
            ob[off] = f2bf(o0[rg]); ob[off + 32 * D] = f2bf(o1[rg]); } }
#pragma unroll
        for (int dkb = 0; dkb < 8; ++dkb) {
#pragma unroll
            for (int q = 0; q < 4; ++q) { const f32x4 dl = *(const LAS f32x4*)(lds + O_DL + (32 * dkb + 8 * q + 4 * hh) * 4);
                S[dkb][4 * q + 0] *= dl.x; S[dkb][4 * q + 1] *= dl.y; S[dkb][4 * q + 2] *= dl.z; S[dkb][4 * q + 3] *= dl.w; }
#pragma unroll
            for (int ks = 0; ks < 4; ++ks) { LAS unsigned char* p = lds + O_KD + (16 * ks + 8 * hh + (i16 >> 2)) * KS + (32 * dkb + 16 * (g4 & 1) + 4 * (i16 & 3)) * 2;
                S[dkb] = MFMA32(cat8(vtr(p), vtr(p + 4 * KS)), Vf[ks], S[dkb]); } }
        __syncthreads();
    }
}
__device__ __forceinline__ void lru_scan_unit(Frame& F, int unit) {
    refresh(F);
    LAS f32x4* SEG = (LAS f32x4*)F.lds;
    const int b = unit >> 5, d = (unit >> 4) & 1, g = unit & 15, cp = F.lane, seg = F.wave, ch = 128 * g + 2 * cp;
    const bf16* la = ((bf16*)(F.ws + WS_LA)) + (size_t)d * M * D + ch; const bf16* bx = ((bf16*)(F.ws + WS_LA)) + (size_t)(2 + d) * M * D + ch; bf16* hs = ((bf16*)(F.ws + WS_HS)) + (size_t)d * M * D + ch;
    const int p0 = 288 * seg;
#define LRU_ROW(p) ((size_t)b * TT + (d == 0 ? ((p) < LC ? TL + (p) : (p) - LC) : ((p) < LC ? TL + LC - 1 - (p) : TL - 1 - ((p) - LC))))
    float h0 = 0.f, h1 = 0.f, A0 = 1.f, A1 = 1.f;
#pragma unroll 8
    for (int i = 0; i < 288; ++i) { const size_t row = LRU_ROW(p0 + i); const unsigned lv = *(const unsigned*)(la + row * D), bv = *(const unsigned*)(bx + row * D);
        const float a0 = __expf(bflo(lv)), a1 = __expf(bfhi(lv)); h0 = a0 * h0 + bflo(bv); h1 = a1 * h1 + bfhi(bv); A0 *= a0; A1 *= a1; }
    __syncthreads();
    SEG[seg * 64 + cp] = (f32x4){A0, h0, A1, h1};
    __syncthreads();
    h0 = 0.f; h1 = 0.f;
    for (int s2 = 0; s2 < seg; ++s2) { const f32x4 v = SEG[s2 * 64 + cp]; h0 = v.x * h0 + v.y; h1 = v.z * h1 + v.w; }
#pragma unroll 8
    for (int i = 0; i < 288; ++i) { const size_t row = LRU_ROW(p0 + i); const unsigned lv = *(const unsigned*)(la + row * D), bv = *(const unsigned*)(bx + row * D);
        const float a0 = __expf(bflo(lv)), a1 = __expf(bfhi(lv)); h0 = a0 * h0 + bflo(bv); h1 = a1 * h1 + bfhi(bv); *(unsigned*)(hs + row * D) = pk2(h0, h1); }
#undef LRU_ROW
    __syncthreads();
}
__device__ __forceinline__ void attn_unit_latent(Frame& F, int idx) {
    const int qb = idx & 7, g = (idx >> 3) & 3, kvh = (idx >> 5) & 3, b = idx >> 7, h = kvh * 4 + g;
    const size_t r0 = (size_t)b * TT + 256 * qb, k0 = (size_t)b * TT;
    att::attn_dense_body(((bf16*)(F.ws + WS_PROJ)) + r0 * NP + C_AQ + h * 128, ((bf16*)(F.ws + WS_PROJ)) + k0 * NP + C_AK + kvh * 128, ((bf16*)(F.ws + WS_PROJ)) + k0 * NP + C_AV + kvh * 128, ((bf16*)(F.ws + WS_OBR)) + (size_t)M * D + r0 * D + h * 128, TT, (char*)F.lds);
    __syncthreads();
}
__device__ __forceinline__ void attn_unit_ctx(Frame& F, int idx) {
    const int h = idx & 15, b = idx >> 4, kvh = h >> 2; const size_t r0 = (size_t)b * TT + TL;
    att::attn_dense_body(((bf16*)(F.ws + WS_PROJ)) + r0 * NP + C_AQ + h * 128, ((bf16*)(F.ws + WS_PROJ)) + r0 * NP + C_AK + kvh * 128, ((bf16*)(F.ws + WS_PROJ)) + r0 * NP + C_AV + kvh * 128, ((bf16*)(F.ws + WS_OBR)) + (size_t)M * D + r0 * D + h * 128, LC, (char*)F.lds);
    __syncthreads();
}
__device__ __forceinline__ void phase_mix(Frame& F) {
    const int w = F.vcu;
    if (w < 64) { if constexpr (EN(6)) gla_unit(F, w); return; }
    const int w2 = w - 64, NA = F.G - 64;
    if constexpr (EN(7)) for (int idx = w2; idx < 512; idx += NA) attn_unit_latent(F, idx);
    for (int it = NA - 1 - w2; it < 192; it += NA) { if (it < 64) { if constexpr (EN(7)) attn_unit_ctx(F, it); } else { if constexpr (EN(8)) lru_scan_unit(F, it - 64); } }
}

__device__ __forceinline__ void phase_post(Frame& F, int l) {
    refresh(F);
    const int gw = F.vcu * NWAVES + F.wave, NGW = F.G * NWAVES, lane = F.lane;
    f32x4 gn0 = *(const f32x4*)(F.ka->in[I_GNG] + l * 512 + 8 * lane), gn1 = *(const f32x4*)(F.ka->in[I_GNG] + l * 512 + 8 * lane + 4);
    for (int row = gw; row < M; row += NGW) {
#pragma unroll
        for (int hd = 0; hd < 4; ++hd) { const int col = hd * 512 + 8 * lane;
            const u32x4 a = *(const u32x4*)(((bf16*)(F.ws + WS_OF)) + (size_t)row * D + col), bb = *(const u32x4*)(((bf16*)(F.ws + WS_OB)) + (size_t)row * D + col), rr = *(const u32x4*)(((bf16*)(F.ws + WS_PROJ)) + (size_t)row * NP + C_GR + col);
            float o[8] = {bflo(a.x) + bflo(bb.x), bfhi(a.x) + bfhi(bb.x), bflo(a.y) + bflo(bb.y), bfhi(a.y) + bfhi(bb.y), bflo(a.z) + bflo(bb.z), bfhi(a.z) + bfhi(bb.z), bflo(a.w) + bflo(bb.w), bfhi(a.w) + bfhi(bb.w)};
            const float r[8] = {bflo(rr.x), bfhi(rr.x), bflo(rr.y), bfhi(rr.y), bflo(rr.z), bfhi(rr.z), bflo(rr.w), bfhi(rr.w)};
            float ss = 0.f;
#pragma unroll
            for (int e = 0; e < 8; ++e) ss += o[e] * o[e];
            const float rstd = 1.0f / sqrtf(wave_sum(ss) * (1.0f / 512.0f) + EPS);
            const float gn[8] = {gn0.x, gn0.y, gn0.z, gn0.w, gn1.x, gn1.y, gn1.z, gn1.w};
#pragma unroll
            for (int e = 0; e < 8; ++e) o[e] = o[e] * rstd * gn[e] * siluf_(r[e]);
            u32x4 w; w.x = pk2(o[0], o[1]); w.y = pk2(o[2], o[3]); w.z = pk2(o[4], o[5]); w.w = pk2(o[6], o[7]);
            *(u32x4*)(((bf16*)(F.ws + WS_OBR)) + (size_t)row * D + col) = w; }
#pragma unroll
        for (int j = 0; j < 4; ++j) { const int col = j * 512 + 8 * lane;
            const u32x4 a = *(const u32x4*)(((bf16*)(F.ws + WS_HS)) + (size_t)row * D + col), bb = *(const u32x4*)(((bf16*)(F.ws + WS_HS)) + ((size_t)M + row) * D + col), yy = *(const u32x4*)(((bf16*)(F.ws + WS_PROJ)) + (size_t)row * NP + C_LY + col);
            float o[8] = {bflo(a.x) + bflo(bb.x), bfhi(a.x) + bfhi(bb.x), bflo(a.y) + bflo(bb.y), bfhi(a.y) + bfhi(bb.y), bflo(a.z) + bflo(bb.z), bfhi(a.z) + bfhi(bb.z), bflo(a.w) + bflo(bb.w), bfhi(a.w) + bfhi(bb.w)};
            const float y[8] = {bflo(yy.x), bfhi(yy.x), bflo(yy.y), bfhi(yy.y), bflo(yy.z), bfhi(yy.z), bflo(yy.w), bfhi(yy.w)};
#pragma unroll
            for (int e = 0; e < 8; ++e) o[e] *= gelu_tanh(y[e]);
            u32x4 w; w.x = pk2(o[0], o[1]); w.y = pk2(o[2], o[3]); w.z = pk2(o[4], o[5]); w.w = pk2(o[6], o[7]);
            *(u32x4*)(((bf16*)(F.ws + WS_OBR)) + ((size_t)2 * M + row) * D + col) = w; }
    }
}
}

using namespace mk;
constexpr int N_PHASES = 42;
typedef KArgs Args;

__global__ void __launch_bounds__(NTHR, 2) hybrid_fwd(Args args) {
    extern __shared__ __attribute__((aligned(16))) unsigned char lds_raw[];
    Frame F;
    F.lds = (LAS unsigned char*)lds_raw;
    F.tid = threadIdx.x; F.lane = F.tid & 63; F.wave = __builtin_amdgcn_readfirstlane(F.tid >> 6);
    F.G = gridDim.x; { const int bx = blockIdx.x; F.vcu = (F.G % 8 == 0) ? (bx % 8) * (F.G / 8) + bx / 8 : bx; }
    F.ka = &args; F.ws = args.ws;
    unsigned char* ws = args.ws;
    volatile LAS unsigned* MISC = (volatile LAS unsigned*)(F.lds + MISC_OFF);
    if (F.tid < 64) MISC[F.tid] = 0u;
    __syncthreads();
    const int lo = args.ph_lo, hi = args.ph_hi;
    XcdBarrier bar; bar.bar = (unsigned*)(ws + WS_CTL) + CW_BAR; bar.x = 0; bar.st = nullptr;
    if (hi - lo > 1) bar = xcd_barrier_post((unsigned*)(ws + WS_CTL) + CW_BAR, MISC + 8);
#define IN(k) (lo <= (k) && (k) < hi)
#define SEAM(k) do { if (hi > (k) + 1) xcd_barrier(bar); } while (0)
    const int c_id = (int)blockIdx.x;

    if (IN(0)) { if constexpr (EN(0)) phase_prologue(F); SEAM(0); }
    for (int l = 0; l < DEPTH; ++l) {
        const int pb = 1 + 10 * l;
        const float* modl = ((float*)(F.ws + WS_MOD)) + (size_t)l * 5 * (6 * D);
        if (IN(pb + 0)) { if constexpr (EN(1)) phase_norm(F, l, F.ka->in[I_NMIX] + (size_t)l * D, 0, 1); SEAM(pb + 0); }
        if (IN(pb + 1)) {
            pg8::Gemm g{((bf16*)(F.ws + WS_U)), (const bf16*)(ws + WS_WIN + l * WIN_L), M, NINP, D}; pg8::StaticOrder S; S.init(M, NINP, F.G, c_id);
            pg8::EpiProj E{((bf16*)(F.ws + WS_PROJ)), ((float*)(F.ws + WS_DEC))};
            if constexpr (EN(2)) pg8::gemm_phase<pg8::EpiProj, pg8::StaticOrder, true, true>(F.lds, g, S, E);
            SEAM(pb + 1); }
        if (IN(pb + 2)) { if constexpr (EN(3)) prep_attn(F, l); if constexpr (EN(4)) prep_gla(F, l); __syncthreads(); if constexpr (EN(5)) prep_lru(F, l); SEAM(pb + 2); }
        if (IN(pb + 3)) { phase_mix(F); SEAM(pb + 3); }
        if (IN(pb + 4)) { if constexpr (EN(9)) phase_post(F, l); SEAM(pb + 4); }
        if (IN(pb + 5)) {
            pg8::Gemm g{((bf16*)(F.ws + WS_OBR)), (const bf16*)(ws + WS_WBR + l * WBR_L), 3 * M, 3 * D, D}; pg8::BranchOrder S; S.init(F.G, c_id);
            pg8::EpiBranch E{((bf16*)(F.ws + WS_PROJ)), F.ka->in[I_BMERGE] + (size_t)l * 3 * D, ((float*)(F.ws + WS_MF)), ((bf16*)(F.ws + WS_MG))};
            if constexpr (EN(10)) pg8::gemm_phase<pg8::EpiBranch, pg8::BranchOrder, true, true>(F.lds, g, S, E);
            SEAM(pb + 5); }
        if (IN(pb + 6)) {
            pg8::Gemm g{((bf16*)(F.ws + WS_MG)), (const bf16*)(ws + WS_WOUT + l * WOUT_L), M, D, D}; pg8::StaticOrder S; S.init(M, D, F.G, c_id);
            pg8::EpiRes E{((float*)(F.ws + WS_H)), modl + 2 * D};
            if constexpr (EN(11)) pg8::gemm_phase<pg8::EpiRes, pg8::StaticOrder, true, true>(F.lds, g, S, E);
            SEAM(pb + 6); }
        if (IN(pb + 7)) { phase_norm(F, l, F.ka->in[I_NFFN] + (size_t)l * D, 3, 4); SEAM(pb + 7); }
        if (IN(pb + 8)) {
            pg8::Gemm g{((bf16*)(F.ws + WS_U)), (const bf16*)(ws + WS_WF1 + l * WF1_L), M, NF1, D}; pg8::StaticOrder S; S.init(M, NF1, F.G, c_id);
            pg8::EpiSwiglu E{((bf16*)(F.ws + WS_ACT))};
            if constexpr (EN(12)) pg8::gemm_phase<pg8::EpiSwiglu, pg8::StaticOrder, true, true>(F.lds, g, S, E);
            SEAM(pb + 8); }
        if (IN(pb + 9)) {
            pg8::Gemm g{((bf16*)(F.ws + WS_ACT)), (const bf16*)(ws + WS_WF2 + l * WF2_L), M, D, FF}; pg8::StaticOrder S; S.init(M, D, F.G, c_id);
            pg8::EpiRes E{((float*)(F.ws + WS_H)), modl + 5 * D};
            if constexpr (EN(13)) pg8::gemm_phase<pg8::EpiRes, pg8::StaticOrder, true, true>(F.lds, g, S, E);
            SEAM(pb + 9); }
    }
    if (IN(41)) { if constexpr (EN(14)) phase_final(F); }
#undef IN
#undef SEAM
}

#ifndef MK_LAUNCH_PER_PHASE
#define MK_LAUNCH_PER_PHASE 0
#endif
extern "C" void kernel_launch(void* const* d_in, const int* in_sizes, int n_in, void* d_out, int out_size, void* d_ws, size_t ws_size, hipStream_t stream) {
    static int grid = 0;
    if (grid == 0) {
        if (n_in != N_INPUTS || out_size != NB * TL * D || ws_size < WS_END) { fprintf(stderr, "kernel_launch: shape mismatch n_in %d out %d ws %zu (need %zu)\n", n_in, out_size, ws_size, (size_t)WS_END); grid = -1; return; }
        int dev = 0, cus = 0, per_cu = 0;
        if (hipGetDevice(&dev) != hipSuccess || hipDeviceGetAttribute(&cus, hipDeviceAttributeMultiprocessorCount, dev) != hipSuccess) { grid = -1; return; }
        if (hipFuncSetAttribute((const void*)hybrid_fwd, hipFuncAttributeMaxDynamicSharedMemorySize, LDS_BYTES) != hipSuccess) { fprintf(stderr, "kernel_launch: hipFuncSetAttribute failed\n"); grid = -1; return; }
        if (hipOccupancyMaxActiveBlocksPerMultiprocessor(&per_cu, (const void*)hybrid_fwd, NTHR, LDS_BYTES) != hipSuccess || per_cu < 1) fprintf(stderr, "kernel_launch: occupancy query says %d\n", per_cu);
        (void)hipGetLastError();
        grid = cus;
        if (grid != 256) fprintf(stderr, "kernel_launch: %d CUs (built for 256)\n", grid);
    }
    if (grid < 0) return;
    (void)hipMemsetAsync((char*)d_ws + WS_CTL, 0, CTL_ZERO_BYTES, stream);
    Args a{};
    for (int i = 0; i < N_INPUTS; ++i) a.in[i] = (const float*)d_in[i];
    a.out = (float*)d_out; a.ws = (unsigned char*)d_ws;
#if MK_LAUNCH_PER_PHASE
    for (int p = 0; p < N_PHASES; ++p) { a.ph_lo = p; a.ph_hi = p + 1; hipLaunchKernelGGL(hybrid_fwd, dim3(grid), dim3(NTHR), LDS_BYTES, stream, a); }
#else
    a.ph_lo = 0; a.ph_hi = N_PHASES; hipLaunchKernelGGL(hybrid_fwd, dim3(grid), dim3(NTHR), LDS_BYTES, stream, a);
#endif
    const hipError_t le = hipPeekAtLastError();
    if (le != hipSuccess) fprintf(stderr, "kernel_launch: launch failed: %s\n", hipGetErrorName(le));
}
```

```cpp
#include <hip/hip_runtime.h>
#include <hip/hip_bf16.h>
#include <cstdio>
#include <cstdint>
#define LAS __attribute__((address_space(3)))
#define GAS __attribute__((address_space(1)))
namespace pg8 {
#define PG8_LAS __attribute__((address_space(3)))
typedef unsigned short bf16_t;
typedef short bf16x8 __attribute__((ext_vector_type(8)));
typedef float f32x4 __attribute__((ext_vector_type(4)));
typedef unsigned u32x4 __attribute__((ext_vector_type(4)));
constexpr int BM = 256, BK = 64, HALF = 128, HTB = HALF * BK * 2  , STAGE_BYTES = 8 * HTB, NXCD = 8, WGM = 8;

__host__ __device__ __forceinline__ int lds_byte(int r, int c) { const int st = (r >> 4) * 2 + (c >> 5), rr = r & 15, cc = c & 31, ob = rr * 64 + cc * 2; return st * 1024 + (ob ^ (((ob >> 9) & 1) << 5)); }
__host__ __device__ __forceinline__ void stage_rc(int b, int& R, int& C) { const int st = b / 1024, sb = b % 1024, swz = sb ^ (((sb >> 9) & 1) << 5); R = (st >> 1) * 16 + swz / 64; C = (st & 1) * 32 + (swz % 64) / 2; }
__host__ __device__ __forceinline__ int perm32(int rho) { const int n = rho >> 4, i = rho & 15; return 8 * (i >> 2) + 4 * n + (i & 3); }

struct Unit { int pm, pn; };
struct Gemm { const bf16_t* A; const bf16_t* Bt; int M, N, K; };

struct StaticOrder {
    int nM, nN, nwg, G, c;
    __host__ __device__ void init(int M, int N, int G_, int c_) { nM = M / BM; nN = N / BM; nwg = nM * nN; G = G_; c = c_; }
    __host__ __device__ bool next(int i, Unit& u) const {
        const long L = (long)i * G + c; if (L >= nwg) return false;
        int wgid = (int)L; { const int q = nwg / NXCD, r = nwg % NXCD, xcd = wgid % NXCD, off = wgid / NXCD; wgid = (xcd < r ? xcd * (q + 1) : r * (q + 1) + (xcd - r) * q) + off; }
        const int nig = WGM * nN, gid = wgid / nig, fm = gid * WGM, gsz = (nM - fm) < WGM ? (nM - fm) : WGM;
        u.pm = fm + ((wgid % nig) % gsz); u.pn = (wgid % nig) / gsz; return true;
    }
    __device__ __forceinline__ void a_ready(const Unit&) const {}
    __device__ __forceinline__ void done(const Unit&) const {}
};

__device__ __forceinline__ unsigned cvt_pk_bf16(float lo, float hi) { unsigned r; asm volatile("v_cvt_pk_bf16_f32 %0, %1, %2" : "=v"(r) : "v"(lo), "v"(hi)); return r; }
template <class Epi, class Sched, bool ALIGN_EPI = false, bool SP2 = false>
__device__ __forceinline__ void gemm_phase(PG8_LAS unsigned char* lds, const Gemm g, const Sched& S, const Epi& E) {
    int tid_ = threadIdx.x; asm volatile("" : "+v"(tid_));
    const int tid = tid_, wid = __builtin_amdgcn_readfirstlane(tid >> 6), lane = tid & 63, wr = wid >> 2, wc = wid & 3, fr = lane & 15, fq = lane >> 4;
    const int K = g.K, nt = K / BK;
    unsigned voffA[2], voffB[2];
#pragma unroll
    for (int i = 0; i < 2; ++i) { int R, C; stage_rc(tid * 16 + i * 8192, R, C); const int Rb = Epi::PERM ? ((R & ~31) + perm32(R & 31)) : R;
        voffA[i] = (unsigned)(R * K + C) * 2u; voffB[i] = (unsigned)(Rb * K + C) * 2u; }
    const size_t kstep = (size_t)(BK * 2);
    const size_t hstep = (size_t)HALF * K * 2;
    const size_t tstep = 2 * hstep;
    const unsigned ldsw = (unsigned)wid * 1024u;
    const int aoff = lds_byte(wr * 64 + fr, fq * 8), boff = lds_byte(wc * 32 + fr, fq * 8);
#define PG8_SA(b, h) (((b) * 2 + (h)) * HTB)
#define PG8_SB(b, h) ((4 + (b) * 2 + (h)) * HTB)
#define PG8_STAGE(bufoff, gbase, voff) do { _Pragma("unroll") for (int _i = 0; _i < 2; ++_i) \
        __builtin_amdgcn_global_load_lds((const unsigned*)((const char*)(gbase) + (voff)[_i]), (PG8_LAS unsigned*)(lds + (bufoff) + ldsw + _i * 8192), 16, 0, 0); } while (0)
#define PG8_LDA(dst, b, h) do { _Pragma("unroll") for (int m = 0; m < 4; ++m) _Pragma("unroll") for (int k = 0; k < 2; ++k) dst[m][k] = *(const PG8_LAS bf16x8*)(lds + PG8_SA(b, h) + aoff + m * 2048 + k * 1024); } while (0)
#define PG8_LDB(dst, b, h) do { _Pragma("unroll") for (int n = 0; n < 2; ++n) _Pragma("unroll") for (int k = 0; k < 2; ++k) dst[n][k] = *(const PG8_LAS bf16x8*)(lds + PG8_SB(b, h) + boff + n * 2048 + k * 1024); } while (0)
#define PG8_MMA(ai, bj, At, Bt) do { __builtin_amdgcn_s_setprio(1); _Pragma("unroll") for (int m = 0; m < 4; ++m) _Pragma("unroll") for (int n = 0; n < 2; ++n) _Pragma("unroll") for (int k = 0; k < 2; ++k) \
        acc[ai][bj][m][n] = __builtin_amdgcn_mfma_f32_16x16x32_bf16(Bt[n][k], At[m][k], acc[ai][bj][m][n], 0, 0, 0); __builtin_amdgcn_s_setprio(0); } while (0)
#define PG8_WAIT_V(n) asm volatile("s_waitcnt vmcnt(" #n ")" ::: "memory")
#define PG8_WAIT_L(n) asm volatile("s_waitcnt lgkmcnt(" #n ")" ::: "memory")
#define PG8_BAR __builtin_amdgcn_s_barrier()
#define PG8_SCHED __builtin_amdgcn_sched_barrier(0)
    Unit cur, nxt; int ui = 0;
    if (!S.next(0, cur)) return;
    f32x4 acc[2][2][4][2];
#pragma unroll
    for (int a = 0; a < 2; ++a)
#pragma unroll
        for (int b = 0; b < 2; ++b)
#pragma unroll
            for (int m = 0; m < 4; ++m)
#pragma unroll
                for (int n = 0; n < 2; ++n) acc[a][b][m][n] = (f32x4){0.f, 0.f, 0.f, 0.f};
    bf16x8 At[4][2], B0[2][2], B1[2][2];
    const char* cA = (const char*)g.A + (size_t)cur.pm * tstep; const char* cB = (const char*)g.Bt + (size_t)cur.pn * tstep;
    S.a_ready(cur);
    if constexpr (SP2) {
        PG8_STAGE(PG8_SB(0, 0), cB, voffB); PG8_STAGE(PG8_SB(0, 1), cB + hstep, voffB); PG8_STAGE(PG8_SA(0, 0), cA, voffA); PG8_STAGE(PG8_SA(0, 1), cA + hstep, voffA);
        if (wr == 1) PG8_BAR;
        PG8_WAIT_V(2); PG8_BAR;
        PG8_STAGE(PG8_SB(1, 0), cB + kstep, voffB); PG8_STAGE(PG8_SA(1, 0), cA + kstep, voffA); PG8_STAGE(PG8_SB(1, 1), cB + hstep + kstep, voffB);
        PG8_WAIT_V(6); PG8_BAR;
    } else {
        PG8_STAGE(PG8_SB(0, 0), cB, voffB); PG8_STAGE(PG8_SA(0, 0), cA, voffA); PG8_STAGE(PG8_SB(0, 1), cB + hstep, voffB); PG8_STAGE(PG8_SA(0, 1), cA + hstep, voffA);
        if (wr == 1) PG8_BAR;
        PG8_WAIT_V(4); PG8_BAR;
        PG8_STAGE(PG8_SB(1, 0), cB + kstep, voffB); PG8_STAGE(PG8_SA(1, 0), cA + kstep, voffA); PG8_STAGE(PG8_SB(1, 1), cB + hstep + kstep, voffB);
        PG8_WAIT_V(6); PG8_BAR;
    }
    for (;;) {
        const bool has_next = S.next(ui + 1, nxt);
        const char* nA = has_next ? (const char*)g.A + (size_t)nxt.pm * tstep : cA; const char* nB = has_next ? (const char*)g.Bt + (size_t)nxt.pn * tstep : cB;
        for (int t = 0; t < nt; t += 2) {
            const bool last = (t == nt - 2);
            const char* a1 = cA + (size_t)(t + 1) * kstep;
            const char* a2 = last ? nA : cA + (size_t)(t + 2) * kstep; const char* b2 = last ? nB : cB + (size_t)(t + 2) * kstep;
            const char* a3 = a2 + kstep; const char* b3 = b2 + kstep;
            if (last && has_next) S.a_ready(nxt);
            if constexpr (SP2) {
            PG8_LDB(B0, 0, 0); PG8_LDB(B1, 0, 1); PG8_SCHED; PG8_LDA(At, 0, 0); PG8_STAGE(PG8_SA(1, 1), a1 + hstep, voffA);
            PG8_WAIT_V(8); PG8_WAIT_L(0); PG8_BAR; PG8_MMA(0, 0, At, B0); PG8_MMA(0, 1, At, B1); PG8_BAR; PG8_SCHED;
            PG8_LDA(At, 0, 1); PG8_STAGE(PG8_SB(0, 0), b2, voffB); PG8_STAGE(PG8_SB(0, 1), b2 + hstep, voffB); PG8_STAGE(PG8_SA(0, 0), a2, voffA);
            PG8_WAIT_V(8); PG8_WAIT_L(0); PG8_BAR; PG8_MMA(1, 0, At, B0); PG8_MMA(1, 1, At, B1); PG8_BAR; PG8_SCHED;
            PG8_LDB(B0, 1, 0); PG8_LDB(B1, 1, 1); PG8_SCHED; PG8_LDA(At, 1, 0); PG8_STAGE(PG8_SA(0, 1), a2 + hstep, voffA);
            PG8_WAIT_V(8); PG8_WAIT_L(0); PG8_BAR; PG8_MMA(0, 0, At, B0); PG8_MMA(0, 1, At, B1); PG8_BAR; PG8_SCHED;
            PG8_LDA(At, 1, 1); PG8_STAGE(PG8_SB(1, 0), b3, voffB); PG8_STAGE(PG8_SB(1, 1), b3 + hstep, voffB); PG8_STAGE(PG8_SA(1, 0), a3, voffA);
            PG8_WAIT_V(8); PG8_WAIT_L(0); PG8_BAR; PG8_MMA(1, 0, At, B0); PG8_MMA(1, 1, At, B1); PG8_BAR; PG8_SCHED;
            } else {
            PG8_LDB(B0, 0, 0); PG8_SCHED; PG8_LDA(At, 0, 0); PG8_STAGE(PG8_SA(1, 1), a1 + hstep, voffA);
            PG8_WAIT_L(8); PG8_BAR; PG8_WAIT_L(0); PG8_MMA(0, 0, At, B0); PG8_BAR; PG8_SCHED;
            PG8_LDB(B1, 0, 1); PG8_STAGE(PG8_SB(0, 0), b2, voffB);
            PG8_BAR; PG8_WAIT_L(0); PG8_MMA(0, 1, At, B1); PG8_BAR;
            PG8_LDA(At, 0, 1); PG8_STAGE(PG8_SA(0, 0), a2, voffA);
            PG8_BAR; PG8_WAIT_L(0); PG8_MMA(1, 0, At, B0); PG8_BAR; PG8_SCHED;
            PG8_STAGE(PG8_SB(0, 1), b2 + hstep, voffB);
            PG8_WAIT_V(6); PG8_BAR; PG8_MMA(1, 1, At, B1); PG8_BAR;
            PG8_LDB(B0, 1, 0); PG8_SCHED; PG8_LDA(At, 1, 0); PG8_STAGE(PG8_SA(0, 1), a2 + hstep, voffA);
            PG8_WAIT_L(8); PG8_BAR; PG8_WAIT_L(0); PG8_MMA(0, 0, At, B0); PG8_BAR; PG8_SCHED;
            PG8_LDB(B1, 1, 1); PG8_STAGE(PG8_SB(1, 0), b3, voffB);
            PG8_BAR; PG8_WAIT_L(0); PG8_MMA(0, 1, At, B1); PG8_BAR;
            PG8_LDA(At, 1, 1); PG8_STAGE(PG8_SA(1, 0), a3, voffA);
            PG8_BAR; PG8_WAIT_L(0); PG8_MMA(1, 0, At, B0); PG8_BAR; PG8_SCHED;
            PG8_STAGE(PG8_SB(1, 1), b3 + hstep, voffB);
            PG8_WAIT_V(6); PG8_BAR; PG8_MMA(1, 1, At, B1); PG8_BAR;
            }
        }
        if constexpr (ALIGN_EPI) { if (wr == 0) PG8_BAR; }
        if constexpr (!Epi::AFTER_DRAIN) { E(acc, cur, wr, wc, fr, fq); S.done(cur); }
        if (!has_next) break;
        if (!E.keep(cur)) {
#pragma unroll
        for (int a = 0; a < 2; ++a)
#pragma unroll
            for (int b = 0; b < 2; ++b)
#pragma unroll
                for (int m = 0; m < 4; ++m)
#pragma unroll
                    for (int n = 0; n < 2; ++n) acc[a][b][m][n] = (f32x4){0.f, 0.f, 0.f, 0.f};
        }
        cur = nxt; cA = nA; cB = nB; ++ui;
        if constexpr (ALIGN_EPI) { if (wr == 1) PG8_BAR; }
    }
    PG8_WAIT_V(0);
    if constexpr (!ALIGN_EPI) { if (wr == 0) PG8_BAR; }
    PG8_BAR;
    if constexpr (Epi::AFTER_DRAIN) { E.fused(acc, cur, wr, wc, fr, fq, lds, wid, lane); S.done(cur); }
#undef PG8_SA
#undef PG8_SB
#undef PG8_STAGE
#undef PG8_LDA
#undef PG8_LDB
#undef PG8_MMA
#undef PG8_WAIT_V
#undef PG8_WAIT_L
#undef PG8_BAR
#undef PG8_SCHED
}
}
#define XB_TMO      128
#define XB_XCNT(j)  (256  + 64 * (j))
#define XB_XSUB(j)  (1280 + 64 * (j))
#define XB_XGEN(j)  (2304 + 64 * (j))
#define XB_TOP      3328
#define XB_TOPGEN   3392
#define XCD_BAR_WORDS 3456
#define XB_SPIN_CAP (1u << 18)

__device__ __forceinline__ unsigned xb_ld(unsigned* p)              { return __hip_atomic_load(p, __ATOMIC_RELAXED, __HIP_MEMORY_SCOPE_AGENT); }
__device__ __forceinline__ unsigned xb_add(unsigned* p, unsigned v) { return __hip_atomic_fetch_add(p, v, __ATOMIC_RELAXED, __HIP_MEMORY_SCOPE_AGENT); }
__device__ __forceinline__ unsigned xb_xcc_id() { return (unsigned)__builtin_amdgcn_s_getreg((3 << 11) | 20) & 0xFu; }
#define XB_SPIN(cond, bar) do { unsigned _sp = 0; while (cond) { __builtin_amdgcn_s_sleep(1); \
    if ((++_sp & 255u) == 0u) { if (xb_ld(&(bar)[XB_TMO])) break; if (_sp > XB_SPIN_CAP) { atomicAdd(&(bar)[XB_TMO], 1u); break; } } } } while (0)

struct XcdBarrier {
    unsigned* bar; unsigned x;
    volatile LAS unsigned* st;
};

__device__ __forceinline__ XcdBarrier xcd_barrier_post(unsigned* bar, volatile LAS unsigned* st) {
    XcdBarrier b; b.bar = bar; b.x = xb_xcc_id(); b.st = st;
    if (threadIdx.x == 0) (void)xb_add(&bar[XB_XCNT(b.x)], 1u);
    return b;
}
__device__ __forceinline__ void xcd_barrier_complete(unsigned* bar, unsigned x, unsigned& nloc, unsigned& nx) {
    const unsigned G = gridDim.x * gridDim.y * gridDim.z;
    unsigned sum, cnt, mine, sp = 0u;
    for (;;) {
        sum = 0u; cnt = 0u; mine = 0u;
#pragma unroll
        for (unsigned j = 0; j < 16; ++j) { const unsigned c = xb_ld(&bar[XB_XCNT(j)]); sum += c; cnt += (c > 0u) ? 1u : 0u; mine = (j == x) ? c : mine; }
        if (sum == G) break;
        __builtin_amdgcn_s_sleep(1);
        if ((++sp & 255u) == 0u) { if (xb_ld(&bar[XB_TMO])) break; if (sp > XB_SPIN_CAP) { atomicAdd(&bar[XB_TMO], 1u); break; } }
    }
    nloc = mine > 0u ? mine : 1u; nx = cnt > 0u ? cnt : 1u;
}

__device__ __forceinline__ void xcd_barrier(const XcdBarrier& b) {
    asm volatile("s_waitcnt vmcnt(0)" ::: "memory");
    __syncthreads();
    if (threadIdx.x == 0) {
        unsigned* bar = b.bar;
        __builtin_amdgcn_s_waitcnt(0);
        unsigned nloc = b.st[0], nx = b.st[1];
        if (nloc == 0u) { xcd_barrier_complete(bar, b.x, nloc, nx); b.st[0] = nloc; b.st[1] = nx; }
        const unsigned old = xb_add(&bar[XB_XSUB(b.x)], 1u);
        const unsigned gen = old / nloc;
        if (old + 1u == (gen + 1u) * nloc) {
            __builtin_amdgcn_fence(__ATOMIC_RELEASE, "agent");
            asm volatile("s_waitcnt vmcnt(0)" ::: "memory");
            const unsigned og = xb_add(&bar[XB_TOP], 1u);
            const unsigned tg = og / nx;
            if (og + 1u == (tg + 1u) * nx) xb_add(&bar[XB_TOPGEN], 1u);
            else XB_SPIN(xb_ld(&bar[XB_TOPGEN]) == tg, bar);
            __builtin_amdgcn_fence(__ATOMIC_ACQUIRE, "agent");
            xb_add(&bar[XB_XGEN(b.x)], 1u);
            asm volatile("s_waitcnt vmcnt(0)" ::: "memory");
        } else {
            XB_SPIN(xb_ld(&bar[XB_XGEN(b.x)]) == gen, bar);
            __builtin_amdgcn_fence(__ATOMIC_ACQUIRE, "agent");
            asm volatile("s_waitcnt vmcnt(0)" ::: "memory");
        }
    }
    __syncthreads();
}
#ifndef PH_MASK
#define PH_MASK 0xFFFFFFFFu
#endif
#define EN(k) (((PH_MASK) >> (k)) & 1u)
#ifndef REP_MASK
#define REP_MASK 0u
#endif
#define RP(k) (((REP_MASK) >> (k)) & 1u)
namespace mk {
typedef unsigned short bf16;
typedef short bf16x8 __attribute__((ext_vector_type(8)));
typedef short s16x4 __attribute__((ext_vector_type(4)));
typedef float f32x2 __attribute__((ext_vector_type(2)));
typedef float f32x4 __attribute__((ext_vector_type(4)));
typedef float f32x16 __attribute__((ext_vector_type(16)));
typedef unsigned u32x2 __attribute__((ext_vector_type(2)));
typedef unsigned u32x4 __attribute__((ext_vector_type(4)));

constexpr int D = 2048, NB = 4, TL = 2048, LC = 256, TT = 2304, M = NB * TT, DEPTH = 4;
constexpr int NIN = 19488, NP = 19456, NINP = 19712, FF = 5632, NF1 = 11264;
constexpr int C_GQ = 0, C_GK = 1024, C_GV = 2048, C_GR = 4096, C_AQ = 6144, C_AK = 8192, C_AV = 8704, C_LX = 9216, C_LY = 11264, C_GATE = 13312;
constexpr float EPS = 1e-6f;
constexpr int NWAVES = 8, NTHR = 512;

enum { I_X = 0, I_C, I_CTX, I_CCTX, I_WMOD, I_BMOD, I_NMIX, I_NFFN, I_WIN, I_GWD, I_GBD, I_GNG, I_QNG, I_KNG, I_CW, I_CB, I_LWA, I_LBA, I_LWI, I_LBI, I_LAM, I_BMERGE, I_WBR, I_WOUT,
       I_WF1, I_WF2, I_FNG, N_INPUTS };

constexpr size_t MiB = 1u << 20;
constexpr size_t WS_CTL = 0, CTL_ZERO_BYTES = 1 * MiB;
constexpr size_t WS_MOD = 1 * MiB, WS_ROPE = 2 * MiB, WS_DEC = 4 * MiB, WS_DL = 6 * MiB, WS_WL = 8 * MiB;
constexpr size_t WS_WIN = 16 * MiB, WIN_L = 77 * MiB;
constexpr size_t WS_WBR = 324 * MiB, WBR_L = 24 * MiB;
constexpr size_t WS_WOUT = 420 * MiB, WOUT_L = 8 * MiB;
constexpr size_t WS_WF1 = 452 * MiB, WF1_L = 44 * MiB;
constexpr size_t WS_WF2 = 628 * MiB, WF2_L = 22 * MiB;
constexpr size_t WS_H = 716 * MiB, WS_U = 788 * MiB, WS_PROJ = 824 * MiB;
constexpr size_t WS_QD = 1166 * MiB, QD_ONE = 18 * MiB;
constexpr size_t WS_OF = 1274 * MiB, WS_OB = 1310 * MiB;
constexpr size_t WS_LA = 1346 * MiB, ACT36 = 36 * MiB;
constexpr size_t WS_HS = 1490 * MiB;
constexpr size_t WS_OBR = 1562 * MiB;
constexpr size_t WS_MF = 1670 * MiB, WS_Y = WS_MF, WS_MG = 1742 * MiB, WS_ACT = 1778 * MiB, WS_END = 1877 * MiB;
static_assert((size_t)NINP * D * 2 == WIN_L && (size_t)M * NP * 2 == 342 * MiB && (size_t)M * D * 4 == 72 * MiB && (size_t)M * FF * 2 == 99 * MiB, "ws map");
constexpr int CW_BAR = 4096;

constexpr int LDS_MAIN = 155648, MISC_OFF = LDS_MAIN, LDS_BYTES = LDS_MAIN + 256;

__device__ __forceinline__ float bf2f(unsigned v) { return __uint_as_float(v << 16); }
__device__ __forceinline__ float bflo(unsigned v) { return __uint_as_float(v << 16); }
__device__ __forceinline__ float bfhi(unsigned v) { return __uint_as_float(v & 0xffff0000u); }
typedef __bf16 bf16x2_t __attribute__((ext_vector_type(2)));
__device__ __forceinline__ unsigned pk2(float lo, float hi) { f32x2 v = {lo, hi}; bf16x2_t b = __builtin_convertvector(v, bf16x2_t); return __builtin_bit_cast(unsigned, b); }
__device__ __forceinline__ bf16 f2bf(float f) { return (bf16)(pk2(f, 0.f) & 0xffffu); }
__device__ __forceinline__ float wave_sum(float v) {
#pragma unroll
    for (int o = 1; o < 64; o <<= 1) v += __shfl_xor(v, o);
    return v;
}
__device__ __forceinline__ float sigmoidf_(float x) { return 1.0f / (1.0f + __expf(-x)); }
__device__ __forceinline__ float siluf_(float x) { return x / (1.0f + __expf(-x)); }
__device__ __forceinline__ float gelu_tanh(float x) { const float u = 1.5957691216f * (x + 0.044715f * x * x * x); return x / (1.0f + __expf(-u)); }
__device__ __forceinline__ int crow(int r, int hi) { return (r & 3) + 8 * (r >> 2) + 4 * hi; }
#define MFMA32(a, b, c) __builtin_amdgcn_mfma_f32_32x32x16_bf16((a), (b), (c), 0, 0, 0)
#define MFMA16(a, b, c) __builtin_amdgcn_mfma_f32_16x16x32_bf16((a), (b), (c), 0, 0, 0)
typedef short v4i16_t __attribute__((ext_vector_type(4)));
__device__ __forceinline__ s16x4 vtr(LAS unsigned char* p) { return __builtin_bit_cast(s16x4, __builtin_amdgcn_ds_read_tr16_b64_v4i16((LAS v4i16_t*)p)); }
__device__ __forceinline__ bf16x8 cat8(s16x4 lo, s16x4 hi) { return __builtin_shufflevector(lo, hi, 0, 1, 2, 3, 4, 5, 6, 7); }

struct KArgs { const float* in[N_INPUTS]; float* out; unsigned char* ws; int ph_lo, ph_hi; };
struct Frame {
    LAS unsigned char* lds;
    int tid, lane, wave, vcu, G;
    const KArgs* ka;
    unsigned char* ws;
};
__device__ __forceinline__ void refresh(Frame& F) { int t = threadIdx.x; asm volatile("" : "+v"(t)); F.tid = t; F.lane = t & 63; F.wave = __builtin_amdgcn_readfirstlane(t >> 6); }
}

namespace pg8 {
__device__ __forceinline__ float ep_sigmoid(float x) { return 1.0f / (1.0f + __expf(-x)); }
struct EpiProj {
    static constexpr bool PERM = true, AFTER_DRAIN = false;
    bf16_t* P; float* DEC;
    __device__ __forceinline__ bool keep(const Unit&) const { return false; }
    __device__ __forceinline__ void operator()(const f32x4 (&acc)[2][2][4][2], const Unit& u, int wr, int wc, int fr, int fq) const {
        const int row0 = u.pm * BM + wr * 64 + fr;
        if (u.pn < 76) {
            const int col0 = u.pn * BM + wc * 32 + 8 * fq;
#pragma unroll
            for (int ai = 0; ai < 2; ++ai)
#pragma unroll
                for (int m = 0; m < 4; ++m) { bf16_t* rowp = P + (size_t)(row0 + ai * HALF + m * 16) * mk::NP + col0;
#pragma unroll
                    for (int bj = 0; bj < 2; ++bj) { const f32x4 v0 = acc[ai][bj][m][0], v1 = acc[ai][bj][m][1];
                        u32x4 w; w.x = cvt_pk_bf16(v0[0], v0[1]); w.y = cvt_pk_bf16(v0[2], v0[3]); w.z = cvt_pk_bf16(v1[0], v1[1]); w.w = cvt_pk_bf16(v1[2], v1[3]);
                        *(u32x4*)(rowp + bj * HALF) = w; } }
        } else if (wc == 0) {
#pragma unroll
            for (int ai = 0; ai < 2; ++ai)
#pragma unroll
                for (int m = 0; m < 4; ++m) { float* rp = DEC + (size_t)(row0 + ai * HALF + m * 16) * 32 + 8 * fq;
                    *(f32x4*)rp = acc[ai][0][m][0]; *(f32x4*)(rp + 4) = acc[ai][0][m][1]; }
        }
    }
};
struct EpiBranch {
    static constexpr bool PERM = true, AFTER_DRAIN = false;
    const bf16_t* P; const float* bmerge; bf16_t* MG;
    __device__ __forceinline__ bool keep(const Unit& u) const { return (u.pn >> 3) < 2; }
    static __device__ __forceinline__ void unpack8(const u32x4 g, const f32x4 b0, const f32x4 b1, float (&x)[8]) {
        x[0] = __uint_as_float(g.x << 16) + b0[0]; x[1] = __uint_as_float(g.x & 0xffff0000u) + b0[1]; x[2] = __uint_as_float(g.y << 16) + b0[2]; x[3] = __uint_as_float(g.y & 0xffff0000u) + b0[3];
        x[4] = __uint_as_float(g.z << 16) + b1[0]; x[5] = __uint_as_float(g.z & 0xffff0000u) + b1[1]; x[6] = __uint_as_float(g.w << 16) + b1[2]; x[7] = __uint_as_float(g.w & 0xffff0000u) + b1[3]; }
    __device__ __forceinline__ void operator()(f32x4 (&acc)[2][2][4][2], const Unit& u, int wr, int wc, int fr, int fq) const {
        const int n = u.pn >> 3, pn = u.pn & 7, pm = u.pm - 36 * n, n1 = n < 2 ? n + 1 : 2;
        const int col0 = pn * BM + wc * 32 + 8 * fq;
        const bf16_t* ga = P + (size_t)pm * BM * mk::NP + mk::C_GATE + n * 2048; const bf16_t* gb = P + (size_t)pm * BM * mk::NP + mk::C_GATE + n1 * 2048;
        const float* ba = bmerge + n * 2048; const float* bb = bmerge + n1 * 2048;
        const unsigned goff = (unsigned)((wr * 64 + fr) * mk::NP + col0);
#pragma unroll
        for (int ai = 0; ai < 2; ++ai)
#pragma unroll
            for (int m = 0; m < 4; ++m) { const unsigned go = goff + (unsigned)((ai * HALF + m * 16) * mk::NP);
#pragma unroll
                for (int bj = 0; bj < 2; ++bj) { float xa[8], xb[8];
                    unpack8(*(const u32x4*)(ga + go + bj * HALF), *(const f32x4*)(ba + col0 + bj * HALF), *(const f32x4*)(ba + col0 + bj * HALF + 4), xa);
                    unpack8(*(const u32x4*)(gb + go + bj * HALF), *(const f32x4*)(bb + col0 + bj * HALF), *(const f32x4*)(bb + col0 + bj * HALF + 4), xb);
#pragma unroll
                    for (int e = 0; e < 8; ++e) { const float num = n < 2 ? 1.0f + __expf(-xb[e]) : 1.0f; xa[e] = num * __builtin_amdgcn_rcpf(1.0f + __expf(-xa[e])); }
#pragma unroll
                    for (int e = 0; e < 4; ++e) { acc[ai][bj][m][0][e] *= xa[e]; acc[ai][bj][m][1][e] *= xa[4 + e]; } }
                if (m & 1) asm volatile("" ::: "memory"); }
        if (n == 2) { bf16_t* ob = MG + (size_t)pm * BM * 2048; const unsigned ooff = (unsigned)((wr * 64 + fr) * 2048 + col0);
#pragma unroll
            for (int ai = 0; ai < 2; ++ai)
#pragma unroll
                for (int m = 0; m < 4; ++m) { const unsigned oo = ooff + (unsigned)((ai * HALF + m * 16) * 2048);
#pragma unroll
                    for (int bj = 0; bj < 2; ++bj) { const f32x4 v0 = acc[ai][bj][m][0], v1 = acc[ai][bj][m][1];
                        u32x4 w; w.x = cvt_pk_bf16(v0[0], v0[1]); w.y = cvt_pk_bf16(v0[2], v0[3]); w.z = cvt_pk_bf16(v1[0], v1[1]); w.w = cvt_pk_bf16(v1[2], v1[3]);
                        *(u32x4*)(ob + oo + bj * HALF) = w; } } }
    }
};
struct EpiRes {
    static constexpr bool PERM = true, AFTER_DRAIN = false;
    bf16_t* Y; const float* gate;
    __device__ __forceinline__ bool keep(const Unit&) const { return false; }
    __device__ __forceinline__ void operator()(const f32x4 (&acc)[2][2][4][2], const Unit& u, int wr, int wc, int fr, int fq) const {
        const int b = u.pm / 9, rt = (u.pm - 9 * b) < 8 ? b : 4;
        const int row0 = u.pm * BM + wr * 64 + fr, col0 = u.pn * BM + wc * 32 + 8 * fq;
        f32x4 gv[2][2];
#pragma unroll
        for (int bj = 0; bj < 2; ++bj)
#pragma unroll
            for (int q = 0; q < 2; ++q) gv[bj][q] = *(const f32x4*)(gate + rt * 12288 + col0 + bj * HALF + 4 * q);
#pragma unroll
        for (int ai = 0; ai < 2; ++ai)
#pragma unroll
            for (int m = 0; m < 4; ++m) { bf16_t* yp = Y + (size_t)(row0 + ai * HALF + m * 16) * 2048 + col0;
#pragma unroll
                for (int bj = 0; bj < 2; ++bj) { const f32x4 v0 = acc[ai][bj][m][0] * gv[bj][0], v1 = acc[ai][bj][m][1] * gv[bj][1];
                    u32x4 w; w.x = cvt_pk_bf16(v0[0], v0[1]); w.y = cvt_pk_bf16(v0[2], v0[3]); w.z = cvt_pk_bf16(v1[0], v1[1]); w.w = cvt_pk_bf16(v1[2], v1[3]);
                    *(u32x4*)(yp + bj * HALF) = w; } }
    }
};
struct EpiSwiglu {
    static constexpr bool PERM = true, AFTER_DRAIN = false;
    bf16_t* ACT;
    __device__ __forceinline__ bool keep(const Unit&) const { return false; }
    __device__ __forceinline__ void operator()(const f32x4 (&acc)[2][2][4][2], const Unit& u, int wr, int wc, int fr, int fq) const {
        const int row0 = u.pm * BM + wr * 64 + fr, col0 = u.pn * HALF + wc * 32 + 8 * fq;
#pragma unroll
        for (int ai = 0; ai < 2; ++ai)
#pragma unroll
            for (int m = 0; m < 4; ++m) { float v[8];
#pragma unroll
                for (int n = 0; n < 2; ++n)
#pragma unroll
                    for (int e = 0; e < 4; ++e) { const float g = acc[ai][0][m][n][e], up = acc[ai][1][m][n][e]; v[4 * n + e] = g / (1.0f + __expf(-g)) * up; }
                u32x4 w; w.x = cvt_pk_bf16(v[0], v[1]); w.y = cvt_pk_bf16(v[2], v[3]); w.z = cvt_pk_bf16(v[4], v[5]); w.w = cvt_pk_bf16(v[6], v[7]);
                *(u32x4*)(ACT + (size_t)(row0 + ai * HALF + m * 16) * mk::FF + col0) = w; }
    }
};
struct BranchOrder {
    StaticOrder so;
    __device__ void init(int G, int c) { so.init(mk::M, 2048, G, c); }
    __device__ bool next(int i, Unit& u) const { const int it = i / 3, n = i - 3 * it; if (!so.next(it, u)) return false; u.pm += 36 * n; u.pn += 8 * n; return true; }
    __device__ __forceinline__ void a_ready(const Unit&) const {}
    __device__ __forceinline__ void done(const Unit&) const {}
};
}

namespace att {
using namespace mk;
constexpr int DH = 128, NW = 8, QBLK = 32, KVBLK = 64;
constexpr float SCALE = 0.088388347648318440f;
constexpr float THR = 8.f;
constexpr int LDQ = NP, LDK = NP, LDO = D;
constexpr int SHM_V = KVBLK * DH * 2, SHM_K = KVBLK * DH * 2, SHM_ATTN = 2 * SHM_V + 2 * SHM_K + NW * 64 * 4;
#define KSWZ(row, colB) ((row) * 256 + ((colB) ^ (((row) & 7) << 4)))
#define SBAR() __builtin_amdgcn_sched_barrier(0)
__device__ __forceinline__ unsigned cvtpk(float lo, float hi) { unsigned r; asm volatile("v_cvt_pk_bf16_f32 %0, %1, %2" : "=v"(r) : "v"(lo), "v"(hi)); return r; }
__device__ __forceinline__ void partialSM(f32x16& p0, f32x16& p1, float& m_reg, float& mn, float& alpha) {
  constexpr float C = SCALE * 1.4426950408889634f;
  float pmax = p0[0];
#pragma unroll
  for (int r = 1; r < 16; ++r) pmax = fmaxf(pmax, p0[r]);
#pragma unroll
  for (int r = 0; r < 16; ++r) pmax = fmaxf(pmax, p1[r]);
  { auto rr = __builtin_amdgcn_permlane32_swap(__float_as_uint(pmax), __float_as_uint(pmax), false, false);
    pmax = fmaxf(__uint_as_float(rr[0]), __uint_as_float(rr[1])); }
  if (__builtin_expect(__all(pmax - m_reg <= THR / SCALE), 1)) { mn = m_reg; alpha = 1.f; }
  else { mn = fmaxf(m_reg, pmax); alpha = __builtin_amdgcn_exp2f((m_reg - mn) * C); m_reg = mn; }
  float mnC = -mn * C;
#pragma unroll
  for (int r = 0; r < 16; ++r) p0[r] = fmaf(p0[r], C, mnC);
#pragma unroll
  for (int r = 0; r < 16; ++r) p1[r] = fmaf(p1[r], C, mnC);
#pragma unroll
  for (int r = 0; r < 16; ++r) p0[r] = __builtin_amdgcn_exp2f(p0[r]);
}
__device__ __forceinline__ void finishSM(f32x16& p0, f32x16& p1, float alpha, float& l_reg, bf16x8& pa0, bf16x8& pa1, bf16x8& pa2, bf16x8& pa3) {
#pragma unroll
  for (int r = 0; r < 16; ++r) p1[r] = __builtin_amdgcn_exp2f(p1[r]);
  float ps = 0;
#pragma unroll
  for (int r = 0; r < 16; ++r) ps += p0[r];
#pragma unroll
  for (int r = 0; r < 16; ++r) ps += p1[r];
  { auto rr = __builtin_amdgcn_permlane32_swap(__float_as_uint(ps), __float_as_uint(ps), false, false);
    ps = __uint_as_float(rr[0]) + __uint_as_float(rr[1]); }
  l_reg = l_reg * alpha + ps;
#define PK4(P, BASE, OUT) do { unsigned a0 = cvtpk(P[BASE + 0], P[BASE + 1]), a1 = cvtpk(P[BASE + 2], P[BASE + 3]);   \
    unsigned b0 = cvtpk(P[BASE + 4], P[BASE + 5]), b1 = cvtpk(P[BASE + 6], P[BASE + 7]);                              \
    auto r0 = __builtin_amdgcn_permlane32_swap(a0, b0, false, false); auto r1 = __builtin_amdgcn_permlane32_swap(a1, b1, false, false); \
    u32x4 w = {r0[0], r1[0], r0[1], r1[1]}; OUT = *reinterpret_cast<bf16x8*>(&w); } while (0)
  PK4(p0, 0, pa0); PK4(p0, 8, pa1); PK4(p1, 0, pa2); PK4(p1, 8, pa3);
#undef PK4
}
__device__ __forceinline__ void qkt(f32x16& p0, f32x16& p1, const bf16* Ks, const bf16x8* qr, int r32, int hi) {
  p0 = f32x16{}; p1 = f32x16{};
#pragma unroll
  for (int d0 = 0; d0 < 8; ++d0) { int cb = (d0 * 16 + hi * 8) * 2;
    bf16x8 b0 = *reinterpret_cast<const bf16x8*>((const char*)Ks + KSWZ(r32, cb));
    bf16x8 b1 = *reinterpret_cast<const bf16x8*>((const char*)Ks + KSWZ(32 + r32, cb));
    p0 = MFMA32(b0, qr[d0], p0);
    p1 = MFMA32(b1, qr[d0], p1); }
}
__device__ __forceinline__ int v_st(int k, int c) { const int kk = (k & ~0xC) | ((k & 4) << 1) | ((k & 8) >> 1); return ((kk >> 3) * 4 + (c >> 5)) * 512 + ((kk & 7) * 32 + (c & 31)) * 2; }
__device__ __forceinline__ int v_rd_base(int lane) { return ((lane & 3) << 3) | (((lane >> 2) & 3) << 6) | (((lane >> 4) & 1) << 5) | (((lane >> 5) & 1) << 8); }
constexpr int v_rd_off(int d0, int ks, int half) { return d0 * 512 + ks * 4096 + half * 2048; }
template <int OFF> __device__ __forceinline__ s16x4 tr_read(int vb) {
  s16x4 r; asm volatile("ds_read_b64_tr_b16 %0, %1 offset:%2" : "=&v"(r) : "v"(vb), "i"(OFF) : "memory"); return r;
}
template <int D0> __device__ __forceinline__ void pv_one(f32x16& od, int vb, bf16x8 pa0, bf16x8 pa1, bf16x8 pa2, bf16x8 pa3) {
  const s16x4 l0 = tr_read<v_rd_off(D0, 0, 0)>(vb), h0 = tr_read<v_rd_off(D0, 0, 1)>(vb), l1 = tr_read<v_rd_off(D0, 1, 0)>(vb), h1 = tr_read<v_rd_off(D0, 1, 1)>(vb);
  const s16x4 l2 = tr_read<v_rd_off(D0, 2, 0)>(vb), h2 = tr_read<v_rd_off(D0, 2, 1)>(vb), l3 = tr_read<v_rd_off(D0, 3, 0)>(vb), h3 = tr_read<v_rd_off(D0, 3, 1)>(vb);
  asm volatile("s_waitcnt lgkmcnt(0)" ::: "memory"); SBAR();
#define PK(L, H) (bf16x8){L[0], L[1], L[2], L[3], H[0], H[1], H[2], H[3]}
  od = MFMA32(pa0, PK(l0, h0), od);
  od = MFMA32(pa1, PK(l1, h1), od);
  od = MFMA32(pa2, PK(l2, h2), od);
  od = MFMA32(pa3, PK(l3, h3), od);
#undef PK
}
__device__ __forceinline__ void pv_d0(f32x16* o, int vb, bf16x8 pa0, bf16x8 pa1, bf16x8 pa2, bf16x8 pa3) {
  pv_one<0>(o[0], vb, pa0, pa1, pa2, pa3); pv_one<1>(o[1], vb, pa0, pa1, pa2, pa3); pv_one<2>(o[2], vb, pa0, pa1, pa2, pa3); pv_one<3>(o[3], vb, pa0, pa1, pa2, pa3);
}
__device__ __forceinline__ void attn_dense_body(const bf16* __restrict__ Qb, const bf16* __restrict__ Kh, const bf16* __restrict__ Vh, bf16* __restrict__ Ob, int seq, char* lds) {
  int tid_ = threadIdx.x; asm volatile("" : "+v"(tid_));
  const int tid = tid_, wid = tid >> 6, lane = tid & 63, r32 = lane & 31, hi = lane >> 5;
  bf16* V_lds = (bf16*)lds; bf16* K_lds = (bf16*)(lds + 2 * SHM_V);
  float* ws = (float*)(lds + 2 * SHM_V + 2 * SHM_K) + wid * 64; float* li_l = ws; float* al_l = ws + 32;
  float m_reg = -1e30f, l_reg = 0; f32x16 o[4] = {}; bf16x8 qr[8];
  const bf16* Qw = Qb + (long)(wid * QBLK + r32) * LDQ + hi * 8;
#pragma unroll
  for (int d0 = 0; d0 < 8; ++d0) qr[d0] = *reinterpret_cast<const bf16x8*>(Qw + d0 * 16);
  const int sr = tid >> 4, sc = (tid & 15) * 8, vst0 = v_st(sr, sc), vst1 = v_st(32 + sr, sc);
  const int vb0 = (int)(uintptr_t)V_lds + v_rd_base(lane);
  struct { bf16x8 vs0, vs1, ks0, ks1; } sr_[2];
  const unsigned go0 = (unsigned)(sr * LDK + sc), go1 = (unsigned)((32 + sr) * LDK + sc);
#define SLOAD(i, k0) do { const bf16* vb_ = Vh + (long)(k0) * LDK; const bf16* kb_ = Kh + (long)(k0) * LDK; \
    sr_[i].vs0 = *reinterpret_cast<const bf16x8*>(vb_ + go0); sr_[i].vs1 = *reinterpret_cast<const bf16x8*>(vb_ + go1); \
    sr_[i].ks0 = *reinterpret_cast<const bf16x8*>(kb_ + go0); sr_[i].ks1 = *reinterpret_cast<const bf16x8*>(kb_ + go1); } while (0)
#define SWRITE(b, i) do { *(bf16x8*)((char*)V_lds + (b) * SHM_V + vst0) = sr_[i].vs0;          \
    *(bf16x8*)((char*)V_lds + (b) * SHM_V + vst1) = sr_[i].vs1; int kc = sc * 2;               \
    *(bf16x8*)((char*)K_lds + (b) * SHM_K + KSWZ(sr, kc)) = sr_[i].ks0;                       \
    *(bf16x8*)((char*)K_lds + (b) * SHM_K + KSWZ(32 + sr, kc)) = sr_[i].ks1; } while (0)
#define SWAIT() asm volatile("s_waitcnt vmcnt(4)" ::: "memory")
#define RESC(a) do { if (__any((a) < 1.f)) { if (hi == 0) al_l[r32] = (a); asm volatile("s_waitcnt lgkmcnt(0)" ::: "memory"); \
    _Pragma("unroll") for (int d = 0; d < 4; ++d) _Pragma("unroll") for (int r = 0; r < 16; ++r) o[d][r] *= al_l[crow(r, hi)]; } } while (0)
  f32x16 pA0, pA1, pB0, pB1; float mnA, mnB, alA, alB; bf16x8 pa0, pa1, pa2, pa3; const int NT = seq / KVBLK;
  constexpr int SE = 0, SO = 1;
  SLOAD(SE, 0); asm volatile("s_waitcnt vmcnt(0)" ::: "memory"); SWRITE(0, SE); __syncthreads();
  qkt(pA0, pA1, K_lds, qr, r32, hi); partialSM(pA0, pA1, m_reg, mnA, alA);
  SLOAD(SO, KVBLK); if (2 < NT) SLOAD(SE, 2 * KVBLK);
  SWAIT(); SWRITE(1, SO); __syncthreads();
  for (int j = 1; j + 1 < NT; j += 2) {
    SBAR(); qkt(pB0, pB1, (bf16*)((char*)K_lds + SHM_K), qr, r32, hi);
    finishSM(pA0, pA1, alA, l_reg, pa0, pa1, pa2, pa3); SBAR();
    SLOAD(SO, (j + 2) * KVBLK); SBAR();
    pv_d0(o, vb0, pa0, pa1, pa2, pa3); partialSM(pB0, pB1, m_reg, mnB, alB);
    __syncthreads(); SWAIT(); SWRITE(0, SE);
    RESC(alB); __syncthreads();
    SBAR(); qkt(pA0, pA1, K_lds, qr, r32, hi);
    finishSM(pB0, pB1, alB, l_reg, pa0, pa1, pa2, pa3); SBAR();
    if (j + 3 < NT) SLOAD(SE, (j + 3) * KVBLK); SBAR();
    pv_d0(o, vb0 + (int)SHM_V, pa0, pa1, pa2, pa3); partialSM(pA0, pA1, m_reg, mnA, alA);
    __syncthreads(); SWAIT(); SWRITE(1, SO);
    RESC(alA); __syncthreads();
  }
  SBAR(); qkt(pB0, pB1, (bf16*)((char*)K_lds + SHM_K), qr, r32, hi);
  finishSM(pA0, pA1, alA, l_reg, pa0, pa1, pa2, pa3); SBAR();
  pv_d0(o, vb0, pa0, pa1, pa2, pa3); partialSM(pB0, pB1, m_reg, mnB, alB);
  __syncthreads(); RESC(alB);
  finishSM(pB0, pB1, alB, l_reg, pa0, pa1, pa2, pa3); SBAR();
  pv_d0(o, vb0 + (int)SHM_V, pa0, pa1, pa2, pa3);
  if (hi == 0) li_l[r32] = l_reg; asm volatile("s_waitcnt lgkmcnt(0)" ::: "memory");
  float rli[16];
#pragma unroll
  for (int r = 0; r < 16; ++r) rli[r] = __builtin_amdgcn_rcpf(li_l[crow(r, hi)]);
  bf16* Ow = Ob + (long)(wid * QBLK) * LDO; const unsigned oo = (unsigned)(4 * hi * LDO + r32);
#pragma unroll
  for (int r = 0; r < 16; ++r) { const unsigned off = oo + (unsigned)(((r & 3) + 8 * (r >> 2)) * LDO);
#pragma unroll
    for (int d0 = 0; d0 < 4; ++d0) Ow[off + d0 * 32] = f2bf(o[d0][r] * rli[r]); }
#undef SLOAD
#undef SWRITE
#undef SWAIT
#undef RESC
}
}

namespace mk {
#define LDS_WAIT() asm volatile("s_waitcnt lgkmcnt(0)" ::: "memory")

__device__ __forceinline__ void transpose_item(const float* W, size_t ldw, bf16* WT, size_t Kd, int k0, int nsrc0, int ndst0, LAS float* scr, int lane) {
#pragma unroll 8
    for (int i = 0; i < 32; ++i) { const int kk = 2 * i + (lane >> 5); scr[kk * 33 + (lane & 31)] = W[(size_t)(k0 + kk) * ldw + nsrc0 + (lane & 31)]; }
    LDS_WAIT(); asm volatile("" ::: "memory");
    const int c = lane & 7;
#pragma unroll
    for (int j = 0; j < 4; ++j) { const int n = (lane >> 3) + 8 * j; const LAS float* s = scr + (8 * c) * 33 + n;
        u32x4 o; o.x = pk2(s[0 * 33], s[1 * 33]); o.y = pk2(s[2 * 33], s[3 * 33]); o.z = pk2(s[4 * 33], s[5 * 33]); o.w = pk2(s[6 * 33], s[7 * 33]);
        *(u32x4*)(WT + (size_t)(ndst0 + n) * Kd + k0 + 8 * c) = o; }
    LDS_WAIT(); asm volatile("" ::: "memory");
}
constexpr int IT_WIN = 32 * 609, IT_WBR = 3 * 32 * 64, IT_WOUT = 32 * 64, IT_WF1 = 32 * 352, IT_WF2 = 88 * 64, IT_LRU = 512;
constexpr int IT_LAYER = IT_WIN + IT_WBR + IT_WOUT + IT_WF1 + IT_WF2 + IT_LRU;

__device__ __forceinline__ void phase_prologue(Frame& F) {
    refresh(F);
    const int gw = F.vcu * NWAVES + F.wave, NGW = F.G * NWAVES, lane = F.lane;
    LAS float* scr = (LAS float*)(F.lds + F.wave * 16384);
    unsigned char* ws = F.ws;
    for (int it = gw; it < DEPTH * IT_LAYER; it += NGW) {
        const int l = it / IT_LAYER; int r = it - l * IT_LAYER;
        if (r < IT_WIN) { const int kb = r / 609, nb = r - kb * 609, ns = 32 * nb; const int nd = ns < 6144 ? ns : (ns < 6176 ? 19456 + (ns - 6144) : ns - 32);
            transpose_item(F.ka->in[I_WIN] + (size_t)l * D * NIN, NIN, (bf16*)(ws + WS_WIN + l * WIN_L), D, 64 * kb, ns, nd, scr, lane); continue; }
        r -= IT_WIN;
        if (r < IT_WBR) { const int n = r / 2048, rr = r - n * 2048, kb = rr >> 6, nb = rr & 63;
            transpose_item(F.ka->in[I_WBR] + ((size_t)l * 3 + n) * D * D, D, (bf16*)(ws + WS_WBR + l * WBR_L), D, 64 * kb, 32 * nb, n * 2048 + 32 * nb, scr, lane); continue; }
        r -= IT_WBR;
        if (r < IT_WOUT) { const int kb = r >> 6, nb = r & 63;
            transpose_item(F.ka->in[I_WOUT] + (size_t)l * D * D, D, (bf16*)(ws + WS_WOUT + l * WOUT_L), D, 64 * kb, 32 * nb, 32 * nb, scr, lane); continue; }
        r -= IT_WOUT;
        if (r < IT_WF1) { const int kb = r / 352, nb = r - kb * 352, ns = 32 * nb; const int up = ns >= FF ? 1 : 0, j = ns - up * FF; const int nd = (j >> 7) * 256 + up * 128 + (j & 127);
            transpose_item(F.ka->in[I_WF1] + (size_t)l * D * NF1, NF1, (bf16*)(ws + WS_WF1 + l * WF1_L), D, 64 * kb, ns, nd, scr, lane); continue; }
        r -= IT_WF1;
        if (r < IT_WF2) { const int kb = r >> 6, nb = r & 63;
            transpose_item(F.ka->in[I_WF2] + (size_t)l * FF * D, D, (bf16*)(ws + WS_WF2 + l * WF2_L), FF, 64 * kb, 32 * nb, 32 * nb, scr, lane); continue; }
        r -= IT_WF2;
        {
            const int sub = r & 7, mat = r >> 3, gate = mat & 1, n = (mat >> 1) & 15, dir = mat >> 5, kb = sub >> 2, nb = sub & 3;
            const float* W = (gate ? F.ka->in[I_LWI] : F.ka->in[I_LWA]) + (((size_t)l * 2 + dir) * 16 + n) * 128 * 128;
            transpose_item(W, 128, ((bf16*)(F.ws + WS_WL)) + ((size_t)l * 16 + n) * 512 * 128, 128, 64 * kb, 32 * nb, (dir * 2 + gate) * 128 + 32 * nb, scr, lane); }
    }
    for (int i = gw * 64 + lane; i < DEPTH * 224 * 256; i += NGW * 64) { const int l = i / (224 * 256), r = i - l * 224 * 256;
        *(u32x4*)((bf16*)(ws + WS_WIN + l * WIN_L) + (size_t)NIN * D + (size_t)r * 8) = (u32x4){0u, 0u, 0u, 0u}; }
    for (int row = gw; row < M; row += NGW) { const int b = row / TT, t = row - b * TT;
        const f32x4* src = (const f32x4*)(t < TL ? F.ka->in[I_X] + ((size_t)b * TL + t) * D : F.ka->in[I_CTX] + ((size_t)b * LC + (t - TL)) * D);
        f32x4* dst = (f32x4*)(((float*)(F.ws + WS_H)) + (size_t)row * D);
#pragma unroll
        for (int j = 0; j < 8; ++j) dst[lane + 64 * j] = src[lane + 64 * j]; }
    for (int i = gw * 64 + lane; i < TL * 64; i += NGW * 64) { const int t = i >> 6, p = i & 63; const int rr = t >> 6, cc = t & 63;
        const float inv = exp2f(-(float)(p & 31) * (13.287712379549449f / 32.0f)); const float ang = (float)(p < 32 ? rr : cc) * inv;
        ((float*)(F.ws + WS_ROPE))[i] = cosf(ang); ((float*)(F.ws + WS_ROPE))[TL * 64 + i] = sinf(ang); }
    __syncthreads();
    LAS float* SC = (LAS float*)F.lds; LAS float* RED = (LAS float*)(F.lds + 40960);
    for (int i = F.tid; i < 5 * D; i += NTHR) { const int rt = i / D, k = i - rt * D; const float c = rt < 4 ? F.ka->in[I_C][rt * D + k] : F.ka->in[I_CCTX][k]; SC[i] = siluf_(c); }
    __syncthreads();
    for (int u = F.vcu; u < DEPTH * 192; u += F.G) { const int l = u / 192, cb = u - l * 192; const int cg = F.tid & 15, ks = F.tid >> 4;
        const float* wp = F.ka->in[I_WMOD] + ((size_t)l * D + ks * 64) * (6 * D) + cb * 64 + cg * 4;
        f32x4 a0 = {0, 0, 0, 0}, a1 = a0, a2 = a0, a3 = a0, a4 = a0;
#pragma unroll 8
        for (int k = 0; k < 64; ++k) { const f32x4 w = *(const f32x4*)(wp + (size_t)k * (6 * D)); const int kk = ks * 64 + k;
            a0 += SC[kk] * w; a1 += SC[D + kk] * w; a2 += SC[2 * D + kk] * w; a3 += SC[3 * D + kk] * w; a4 += SC[4 * D + kk] * w; }
        *(LAS f32x4*)(RED + (ks * 5 + 0) * 64 + cg * 4) = a0; *(LAS f32x4*)(RED + (ks * 5 + 1) * 64 + cg * 4) = a1; *(LAS f32x4*)(RED + (ks * 5 + 2) * 64 + cg * 4) = a2;
        *(LAS f32x4*)(RED + (ks * 5 + 3) * 64 + cg * 4) = a3; *(LAS f32x4*)(RED + (ks * 5 + 4) * 64 + cg * 4) = a4;
        __syncthreads();
        if (F.tid < 320) { const int rt = F.tid >> 6, c = F.tid & 63; float s = F.ka->in[I_BMOD][(size_t)l * 6 * D + cb * 64 + c];
#pragma unroll 8
            for (int k2 = 0; k2 < 32; ++k2) s += RED[(k2 * 5 + rt) * 64 + c];
            ((float*)(F.ws + WS_MOD))[((size_t)l * 5 + rt) * (6 * D) + cb * 64 + c] = s; }
        __syncthreads();
    }
}

__device__ __forceinline__ void phase_norm(Frame& F, int l, const float* gain, int i_shift, int i_scale, bool has_y) {
    refresh(F);
    const int gw = F.vcu * NWAVES + F.wave, NGW = F.G * NWAVES, lane = F.lane;
    for (int row = gw; row < M; row += NGW) { const int b = row / TT, t = row - b * TT, rt = t < TL ? b : 4;
        f32x4* hp = (f32x4*)(((float*)(F.ws + WS_H)) + (size_t)row * D); f32x4 v[8]; float ss = 0.f;
#pragma unroll
        for (int j = 0; j < 8; ++j) v[j] = hp[lane + 64 * j];
        if (has_y) { const u32x2* yp = (const u32x2*)(((bf16*)(F.ws + WS_Y)) + (size_t)row * D);
#pragma unroll
            for (int j = 0; j < 8; ++j) { const u32x2 y = yp[lane + 64 * j]; v[j].x += bflo(y.x); v[j].y += bfhi(y.x); v[j].z += bflo(y.y); v[j].w += bfhi(y.y); hp[lane + 64 * j] = v[j]; } }
#pragma unroll
        for (int j = 0; j < 8; ++j) ss += (v[j].x * v[j].x + v[j].y * v[j].y) + (v[j].z * v[j].z + v[j].w * v[j].w);
        const float rstd = 1.0f / sqrtf(wave_sum(ss) * (1.0f / D) + EPS);
        const float* mod = ((float*)(F.ws + WS_MOD)) + ((size_t)l * 5 + rt) * (6 * D);
        u32x2* up = (u32x2*)(((bf16*)(F.ws + WS_U)) + (size_t)row * D);
#pragma unroll
        for (int j = 0; j < 8; ++j) { const int c4 = lane + 64 * j; const f32x4 g = ((const f32x4*)gain)[c4], sc = ((const f32x4*)(mod + i_scale * D))[c4], sh = ((const f32x4*)(mod + i_shift * D))[c4];
            const f32x4 o = (v[j] * rstd * g) * (sc + 1.0f) + sh; u32x2 w; w.x = pk2(o.x, o.y); w.y = pk2(o.z, o.w); up[c4] = w; } }
}
__device__ __forceinline__ void phase_final(Frame& F) {
    refresh(F);
    const int gw = F.vcu * NWAVES + F.wave, NGW = F.G * NWAVES, lane = F.lane; const float* gain = F.ka->in[I_FNG];
    for (int idx = gw; idx < NB * TL; idx += NGW) { const int b = idx / TL, t = idx - b * TL; const size_t row = (size_t)b * TT + t;
        const f32x4* hp = (const f32x4*)(((float*)(F.ws + WS_H)) + row * D); const u32x2* yp = (const u32x2*)(((bf16*)(F.ws + WS_Y)) + row * D); f32x4 v[8]; float ss = 0.f;
#pragma unroll
        for (int j = 0; j < 8; ++j) { v[j] = hp[lane + 64 * j]; const u32x2 y = yp[lane + 64 * j]; v[j].x += bflo(y.x); v[j].y += bfhi(y.x); v[j].z += bflo(y.y); v[j].w += bfhi(y.y);
            ss += (v[j].x * v[j].x + v[j].y * v[j].y) + (v[j].z * v[j].z + v[j].w * v[j].w); }
        const float rstd = 1.0f / sqrtf(wave_sum(ss) * (1.0f / D) + EPS);
        f32x4* op = (f32x4*)(F.ka->out + (size_t)idx * D);
#pragma unroll
        for (int j = 0; j < 8; ++j) { const int c4 = lane + 64 * j; op[c4] = v[j] * rstd * ((const f32x4*)gain)[c4]; } }
}

__device__ __forceinline__ void prep_attn(Frame& F, int l) {
    refresh(F);
    const int gw = F.vcu * NWAVES + F.wave, NGW = F.G * NWAVES, lane = F.lane;
    const float gq0 = F.ka->in[I_QNG][l * 128 + 2 * lane], gq1 = F.ka->in[I_QNG][l * 128 + 2 * lane + 1], gk0 = F.ka->in[I_KNG][l * 128 + 2 * lane], gk1 = F.ka->in[I_KNG][l * 128 + 2 * lane + 1];
    for (int row = gw; row < M; row += NGW) { const int t = row % TT; const bool lat = t < TL;
        unsigned* base = (unsigned*)(((bf16*)(F.ws + WS_PROJ)) + (size_t)row * NP + C_AQ) + lane;
        float cs = 1.f, sn = 0.f; if (lat) { cs = ((float*)(F.ws + WS_ROPE))[t * 64 + lane]; sn = ((float*)(F.ws + WS_ROPE))[TL * 64 + t * 64 + lane]; }
        unsigned x[20];
#pragma unroll
        for (int h = 0; h < 20; ++h) x[h] = base[h * 64];
#pragma unroll
        for (int h = 0; h < 20; ++h) { const float x1 = bflo(x[h]), x2 = bfhi(x[h]); const float ss = wave_sum(x1 * x1 + x2 * x2);
            const float rstd = 1.0f / sqrtf(ss * (1.0f / 128.0f) + EPS); const float y1 = x1 * rstd * (h < 16 ? gq0 : gk0), y2 = x2 * rstd * (h < 16 ? gq1 : gk1);
            base[h * 64] = pk2(y1 * cs - y2 * sn, y1 * sn + y2 * cs); } }
}
__device__ __forceinline__ void prep_gla(Frame& F, int l) {
    refresh(F);
    LAS float* DECs = (LAS float*)F.lds;
    const int tid = F.tid, dir = F.wave >> 2, cp = tid & 255;
    for (int u = F.vcu; u < 288; u += F.G) { const int b = u / 72, rem = u - b * 72, c = rem >> 1, half = rem & 1; const size_t R0 = (size_t)b * TT + 64 * c;
        __syncthreads();
        *(LAS f32x4*)(DECs + tid * 4) = *(const f32x4*)(((float*)(F.ws + WS_DEC)) + R0 * 32 + tid * 4);
        __syncthreads();
        const int k0 = half * 512 + 2 * cp;
        f32x2 wv[16];
#pragma unroll
        for (int r = 0; r < 16; ++r) wv[r] = *(const f32x2*)(F.ka->in[I_GWD] + (((size_t)l * 2 + dir) * 16 + r) * 1024 + k0);
        const f32x2 bd = *(const f32x2*)(F.ka->in[I_GBD] + ((size_t)l * 2 + dir) * 1024 + k0);
        const bf16* pq = ((bf16*)(F.ws + WS_PROJ)) + R0 * NP + C_GQ; const bf16* pk = ((bf16*)(F.ws + WS_PROJ)) + R0 * NP + C_GK;
        bf16* QDp = ((bf16*)(F.ws + WS_QD)) + ((size_t)dir * M + R0) * 1024; bf16* KNp = ((bf16*)(F.ws + WS_QD)) + ((size_t)(2 + dir) * M + R0) * 1024;
        f32x2 run = {0.f, 0.f};
#pragma unroll 8
        for (int i = 0; i < 64; ++i) { const int t = dir ? 63 - i : i; f32x2 z = bd;
#pragma unroll
            for (int r4 = 0; r4 < 4; ++r4) { const f32x4 dv = *(const LAS f32x4*)(DECs + t * 32 + dir * 16 + 4 * r4);
                z += dv.x * wv[4 * r4] + dv.y * wv[4 * r4 + 1] + dv.z * wv[4 * r4 + 2] + dv.w * wv[4 * r4 + 3]; }
            run.x += (fminf(z.x, 0.f) - __logf(1.0f + __expf(-fabsf(z.x)))) * 0.0625f; run.y += (fminf(z.y, 0.f) - __logf(1.0f + __expf(-fabsf(z.y)))) * 0.0625f;
            const unsigned q2 = *(const unsigned*)(pq + (unsigned)(t * NP + k0)), k2 = *(const unsigned*)(pk + (unsigned)(t * NP + k0));
            const float e0 = __expf(run.x), e1 = __expf(run.y), n0 = __expf(-run.x), n1 = __expf(-run.y);
            *(unsigned*)(QDp + (unsigned)(t * 1024 + k0)) = pk2(bflo(q2) * 0.0625f * e0, bfhi(q2) * 0.0625f * e1);
            *(unsigned*)(KNp + (unsigned)(t * 1024 + k0)) = pk2(bflo(k2) * n0, bfhi(k2) * n1); }
        { f32x2 dl; dl.x = __expf(run.x); dl.y = __expf(run.y); *(f32x2*)(((float*)(F.ws + WS_DL)) + ((size_t)dir * 144 + b * 36 + c) * 1024 + k0) = dl; }
    }
}
__device__ __forceinline__ void prep_lru(Frame& F, int l) {
    refresh(F);
    constexpr int XBS = 272, XFS = 528, O_XF = 64 * XBS;
    LAS unsigned char* lds = F.lds;
    const int tid = F.tid, lane = F.lane, wv = F.wave, i16 = lane & 15, g4 = lane >> 4;
    const int n = F.vcu & 15, slot = F.vcu >> 4, nslot = F.G >> 4;
    bf16x8 Bf[4][4];
#pragma unroll
    for (int gi = 0; gi < 4; ++gi)
#pragma unroll
        for (int ks = 0; ks < 4; ++ks) Bf[gi][ks] = *(const bf16x8*)(((bf16*)(F.ws + WS_WL)) + (((size_t)l * 16 + n) * 512 + gi * 128 + 16 * wv + i16) * 128 + 32 * ks + 8 * g4);
    const int C = 128 * n + 16 * wv + i16;
    float ba[2], bi[2], sp8[2];
#pragma unroll
    for (int d = 0; d < 2; ++d) { ba[d] = F.ka->in[I_LBA][((size_t)l * 2 + d) * D + C]; bi[d] = F.ka->in[I_LBI][((size_t)l * 2 + d) * D + C];
        const float lam = F.ka->in[I_LAM][((size_t)l * 2 + d) * D + C]; sp8[d] = 8.0f * (fmaxf(-lam, 0.f) + __logf(1.0f + __expf(-fabsf(lam)))); }
    const int cgp = tid & 15, tk = tid >> 4; const int cch = 128 * n + 8 * cgp;
    for (int tt = slot; tt < M / 64; tt += nslot) { const int R0 = 64 * tt, b = R0 / TT, tq = R0 - b * TT;
        const int seq_lo = tq < TL ? b * TT : b * TT + TL, seq_hi = tq < TL ? b * TT + TL : (b + 1) * TT;
        f32x4 cw[4][2], cbv[2];
#pragma unroll
        for (int j = 0; j < 4; ++j) { cw[j][0] = *(const f32x4*)(F.ka->in[I_CW] + ((size_t)l * 4 + j) * D + cch); cw[j][1] = *(const f32x4*)(F.ka->in[I_CW] + ((size_t)l * 4 + j) * D + cch + 4); }
        cbv[0] = *(const f32x4*)(F.ka->in[I_CB] + (size_t)l * D + cch); cbv[1] = *(const f32x4*)(F.ka->in[I_CB] + (size_t)l * D + cch + 4);
#pragma unroll
        for (int q = 0; q < 2; ++q) { const int tok = tk + 32 * q, row = R0 + tok; f32x4 a0 = cbv[0], a1 = cbv[1];
#pragma unroll
            for (int j = 0; j < 4; ++j) { const int rr = row + j - 2; u32x4 xv = {0u, 0u, 0u, 0u};
                if (rr >= seq_lo && rr < seq_hi) xv = *(const u32x4*)(((bf16*)(F.ws + WS_PROJ)) + (size_t)rr * NP + C_LX + cch);
                f32x4 x0 = {bflo(xv.x), bfhi(xv.x), bflo(xv.y), bfhi(xv.y)}, x1 = {bflo(xv.z), bfhi(xv.z), bflo(xv.w), bfhi(xv.w)};
                a0 += cw[j][0] * x0; a1 += cw[j][1] * x1; }
            *(LAS f32x4*)(lds + O_XF + tok * XFS + cgp * 32) = a0; *(LAS f32x4*)(lds + O_XF + tok * XFS + cgp * 32 + 16) = a1;
            u32x4 w; w.x = pk2(a0.x, a0.y); w.y = pk2(a0.z, a0.w); w.z = pk2(a1.x, a1.y); w.w = pk2(a1.z, a1.w);
            *(LAS u32x4*)(lds + tok * XBS + cgp * 16) = w; }
        __syncthreads();
        f32x4 acc[4][4];
#pragma unroll
        for (int tb = 0; tb < 4; ++tb)
#pragma unroll
            for (int gi = 0; gi < 4; ++gi) acc[tb][gi] = (f32x4){0.f, 0.f, 0.f, 0.f};
#pragma unroll
        for (int tb = 0; tb < 4; ++tb)
#pragma unroll
            for (int ks = 0; ks < 4; ++ks) { const bf16x8 a = *(const LAS bf16x8*)(lds + (16 * tb + i16) * XBS + (32 * ks + 8 * g4) * 2);
#pragma unroll
                for (int gi = 0; gi < 4; ++gi) acc[tb][gi] = MFMA16(a, Bf[gi][ks], acc[tb][gi]); }
        const int first0 = b * TT + TL, first1 = b * TT + TL + LC - 1;
#pragma unroll
        for (int tb = 0; tb < 4; ++tb)
#pragma unroll
            for (int rg = 0; rg < 4; ++rg) { const int tok = 16 * tb + 4 * g4 + rg, row = R0 + tok; const float x = *(const LAS float*)(lds + O_XF + tok * XFS + (16 * wv + i16) * 4);
#pragma unroll
                for (int d = 0; d < 2; ++d) { const float r = sigmoidf_(acc[tb][2 * d][rg] + ba[d]), ig = sigmoidf_(acc[tb][2 * d + 1][rg] + bi[d]);
                    const float la = -r * sp8[d], a = __expf(la); float mult = sqrtf(fmaxf(1.0f - a * a, 0.f)); if (row == (d ? first1 : first0)) mult = 1.0f;
                    ((bf16*)(F.ws + WS_LA))[((size_t)d * M + row) * D + C] = f2bf(la); ((bf16*)(F.ws + WS_LA))[((size_t)(2 + d) * M + row) * D + C] = f2bf(mult * ig * x); } }
        __syncthreads();
    }
}

__device__ __forceinline__ void gla_unit(Frame& F, int unit) {
    refresh(F);
    constexpr int QS = 528, KS = 576, AS = 144;
    constexpr int O_QD = 0, O_KN = 33792, O_KD = 67584, O_V = 104448, O_ATT = 141312, O_DL = 150528;
    LAS unsigned char* lds = F.lds;
    const int wv = F.wave;
    const int b = unit >> 4, hd = (unit >> 2) & 3, dir = (unit >> 1) & 1, half = unit & 1;
    const bf16* gQD = ((bf16*)(F.ws + WS_QD)) + (size_t)dir * M * 1024 + hd * 256; const bf16* gKN = ((bf16*)(F.ws + WS_QD)) + (size_t)(2 + dir) * M * 1024 + hd * 256;
    const bf16* gV = ((bf16*)(F.ws + WS_PROJ)) + C_GV + hd * 512 + half * 256;
    bf16* gO = (dir ? ((bf16*)(F.ws + WS_OB)) : ((bf16*)(F.ws + WS_OF))) + hd * 512 + half * 256 + 32 * wv;
    const float* gDL = ((float*)(F.ws + WS_DL)) + ((size_t)dir * 144 + b * 36) * 1024 + hd * 256;
    f32x16 S[8];
#pragma unroll
    for (int i = 0; i < 8; ++i) S[i] = f32x16{};
    u32x4 pq[4], pn[4], pv[4]; f32x4 pdl;
#define GLA_CHUNK(s_) (dir ? 35 - (s_) : ((s_) < 4 ? 32 + (s_) : (s_) - 4))
#define GLA_PREFETCH(s_) do { const int c_ = GLA_CHUNK(s_); const size_t R_ = (size_t)b * TT + 64 * c_; \
        _Pragma("unroll") for (int i = 0; i < 4; ++i) { pq[i] = *(const u32x4*)(gQD + (R_ + 16 * i) * 1024 + vq); pn[i] = *(const u32x4*)(gKN + (R_ + 16 * i) * 1024 + vq); } } while (0)
    { const int tid = F.tid; const unsigned vq = (unsigned)((tid >> 5) * 1024 + 8 * (tid & 31)); GLA_PREFETCH(0); }
    for (int s = 0; s < 36; ++s) {
        int t_ = F.tid; asm volatile("" : "+v"(t_));
        const int tid = t_, lane = tid & 63, r32 = lane & 31, hh = lane >> 5, i16 = lane & 15, g4 = lane >> 4;
        const unsigned vq = (unsigned)((tid >> 5) * 1024 + 8 * (tid & 31)), vv = (unsigned)((tid >> 5) * NP + 8 * (tid & 31));
        LAS unsigned char* lq = lds + (tid >> 5) * QS + 16 * (tid & 31); LAS unsigned char* lk = lds + (tid >> 5) * KS + 16 * (tid & 31);
        const int c = GLA_CHUNK(s); const size_t R0 = (size_t)b * TT + 64 * c;
#pragma unroll
        for (int i = 0; i < 4; ++i) { *(LAS u32x4*)(lq + O_QD + i * 16 * QS) = pq[i]; *(LAS u32x4*)(lq + O_KN + i * 16 * QS) = pn[i]; *(LAS u32x4*)(lk + O_KD + i * 16 * KS) = pn[i]; }
#pragma unroll
        for (int i = 0; i < 4; ++i) pv[i] = *(const u32x4*)(gV + (R0 + 16 * i) * NP + vv);
        pdl = *(const f32x4*)(gDL + (size_t)c * 1024 + (tid & 63) * 4);
        __syncthreads();
        { const int ib = wv >> 1, jb0 = 2 * (wv & 1); f32x4 at0 = {0.f, 0.f, 0.f, 0.f}, at1 = at0;
#pragma unroll
            for (int ks = 0; ks < 8; ++ks) { const int cb = (32 * ks + 8 * g4) * 2;
                const bf16x8 a = *(const LAS bf16x8*)(lds + O_QD + (16 * ib + i16) * QS + cb);
                const bf16x8 b0 = *(const LAS bf16x8*)(lds + O_KN + (16 * jb0 + i16) * QS + cb), b1 = *(const LAS bf16x8*)(lds + O_KN + (16 * (jb0 + 1) + i16) * QS + cb);
                at0 = MFMA16(a, b0, at0); at1 = MFMA16(a, b1, at1); }
#pragma unroll
            for (int rg = 0; rg < 4; ++rg) { const int i = 16 * ib + 4 * g4 + rg, j0 = 16 * jb0 + i16, j1 = j0 + 16;
                const bool k0 = dir ? (j0 >= i) : (j0 <= i), k1 = dir ? (j1 >= i) : (j1 <= i);
                *(LAS bf16*)(lds + O_ATT + i * AS + j0 * 2) = k0 ? f2bf(at0[rg]) : (bf16)0; *(LAS bf16*)(lds + O_ATT + i * AS + j1 * 2) = k1 ? f2bf(at1[rg]) : (bf16)0; } }
        f32x16 o0 = f32x16{}, o1 = f32x16{};
#pragma unroll
        for (int dkb = 0; dkb < 8; ++dkb)
#pragma unroll
            for (int st = 0; st < 2; ++st) { u32x4 pb; pb.x = pk2(S[dkb][8 * st + 0], S[dkb][8 * st + 1]); pb.y = pk2(S[dkb][8 * st + 2], S[dkb][8 * st + 3]);
                pb.z = pk2(S[dkb][8 * st + 4], S[dkb][8 * st + 5]); pb.w = pk2(S[dkb][8 * st + 6], S[dkb][8 * st + 7]); const bf16x8 bfr = __builtin_bit_cast(bf16x8, pb);
                const int dko = (32 * dkb + 16 * st + 4 * hh) * 2;
                const s16x4 l0 = *(const LAS s16x4*)(lds + O_QD + r32 * QS + dko), h0 = *(const LAS s16x4*)(lds + O_QD + r32 * QS + dko + 16);
                const s16x4 l1 = *(const LAS s16x4*)(lds + O_QD + (32 + r32) * QS + dko), h1 = *(const LAS s16x4*)(lds + O_QD + (32 + r32) * QS + dko + 16);
                o0 = MFMA32(cat8(l0, h0), bfr, o0); o1 = MFMA32(cat8(l1, h1), bfr, o1); }
#pragma unroll
        for (int i = 0; i < 4; ++i) *(LAS u32x4*)(lk + O_V + i * 16 * KS) = pv[i];
        if (tid < 64) *(LAS f32x4*)(lds + O_DL + tid * 16) = pdl;
        __syncthreads();
        bf16x8 Vf[4];
#pragma unroll
        for (int ks = 0; ks < 4; ++ks) { LAS unsigned char* p = lds + O_V + (16 * ks + 8 * hh + (i16 >> 2)) * KS + (32 * wv + 16 * (g4 & 1) + 4 * (i16 & 3)) * 2;
            Vf[ks] = cat8(vtr(p), vtr(p + 4 * KS)); }
#pragma unroll
        for (int ks = 0; ks < 4; ++ks) { const int cb = (16 * ks + 8 * hh) * 2;
            const bf16x8 a0 = *(const LAS bf16x8*)(lds + O_ATT + r32 * AS + cb), a1 = *(const LAS bf16x8*)(lds + O_ATT + (32 + r32) * AS + cb);
            o0 = MFMA32(a0, Vf[ks], o0); o1 = MFMA32(a1, Vf[ks], o1); }
        { bf16* ob = gO + R0 * D; const unsigned lo_ = (unsigned)(4 * hh * D + r32);
#pragma unroll
          for (int rg = 0; rg < 16; ++rg) { const unsigned off = lo_ + (unsigned)(((rg & 3) + 8 * (rg >> 2)) * D);
            ob[off] = f2bf(o0[rg]); ob[off + 32 * D] = f2bf(o1[rg]); } }
        if (s + 1 < 36) GLA_PREFETCH(s + 1);
#pragma unroll
        for (int dkb = 0; dkb < 8; ++dkb) {
#pragma unroll
            for (int ks = 0; ks < 4; ++ks) { LAS unsigned char* p = lds + O_KD + (16 * ks + 8 * hh + (i16 >> 2)) * KS + (32 * dkb + 16 * (g4 & 1) + 4 * (i16 & 3)) * 2;
                S[dkb] = MFMA32(cat8(vtr(p), vtr(p + 4 * KS)), Vf[ks], S[dkb]); }
#pragma unroll
            for (int q = 0; q < 4; ++q) { const f32x4 dl = *(const LAS f32x4*)(lds + O_DL + (32 * dkb + 8 * q + 4 * hh) * 4);
                S[dkb][4 * q + 0] *= dl.x; S[dkb][4 * q + 1] *= dl.y; S[dkb][4 * q + 2] *= dl.z; S[dkb][4 * q + 3] *= dl.w; } }
        __syncthreads();
    }
#undef GLA_CHUNK
#undef GLA_PREFETCH
}
__device__ __forceinline__ void lru_scan_unit(Frame& F, int unit) {
    refresh(F);
    LAS float* SEG = (LAS float*)F.lds;
    const int b = unit >> 5, d = (unit >> 4) & 1, g = unit & 15, cg = F.lane & 15, seg = F.wave * 4 + (F.lane >> 4), ch = 128 * g + 8 * cg;
    const bf16* la = ((bf16*)(F.ws + WS_LA)) + (size_t)d * M * D + ch; const bf16* bx = ((bf16*)(F.ws + WS_LA)) + (size_t)(2 + d) * M * D + ch; bf16* hs = ((bf16*)(F.ws + WS_HS)) + (size_t)d * M * D + ch;
    const int p0 = 72 * seg;
#define LRU_ROW(p) ((size_t)b * TT + (d == 0 ? ((p) < LC ? TL + (p) : (p) - LC) : ((p) < LC ? TL + LC - 1 - (p) : TL - 1 - ((p) - LC))))
    float h[8], A[8];
#pragma unroll
    for (int e = 0; e < 8; ++e) { h[e] = 0.f; A[e] = 1.f; }
#pragma unroll 8
    for (int i = 0; i < 72; ++i) { const size_t row = LRU_ROW(p0 + i); const u32x4 lv = *(const u32x4*)(la + row * D), bv = *(const u32x4*)(bx + row * D);
        const unsigned lw[4] = {lv.x, lv.y, lv.z, lv.w}, bw[4] = {bv.x, bv.y, bv.z, bv.w};
#pragma unroll
        for (int e = 0; e < 4; ++e) { const float a0 = __expf(bflo(lw[e])), a1 = __expf(bfhi(lw[e]));
            h[2 * e] = a0 * h[2 * e] + bflo(bw[e]); h[2 * e + 1] = a1 * h[2 * e + 1] + bfhi(bw[e]); A[2 * e] *= a0; A[2 * e + 1] *= a1; } }
    __syncthreads();
    { LAS float* sp = SEG + (seg * 16 + cg) * 16;
      *(LAS f32x4*)(sp) = (f32x4){A[0], A[1], A[2], A[3]}; *(LAS f32x4*)(sp + 4) = (f32x4){A[4], A[5], A[6], A[7]};
      *(LAS f32x4*)(sp + 8) = (f32x4){h[0], h[1], h[2], h[3]}; *(LAS f32x4*)(sp + 12) = (f32x4){h[4], h[5], h[6], h[7]}; }
    __syncthreads();
#pragma unroll
    for (int e = 0; e < 8; ++e) h[e] = 0.f;
    for (int s2 = 0; s2 < seg; ++s2) { const LAS float* sp = SEG + (s2 * 16 + cg) * 16;
        const f32x4 a0 = *(const LAS f32x4*)(sp), a1 = *(const LAS f32x4*)(sp + 4), h0 = *(const LAS f32x4*)(sp + 8), h1 = *(const LAS f32x4*)(sp + 12);
        h[0] = a0.x * h[0] + h0.x; h[1] = a0.y * h[1] + h0.y; h[2] = a0.z * h[2] + h0.z; h[3] = a0.w * h[3] + h0.w;
        h[4] = a1.x * h[4] + h1.x; h[5] = a1.y * h[5] + h1.y; h[6] = a1.z * h[6] + h1.z; h[7] = a1.w * h[7] + h1.w; }
#pragma unroll 8
    for (int i = 0; i < 72; ++i) { const size_t row = LRU_ROW(p0 + i); const u32x4 lv = *(const u32x4*)(la + row * D), bv = *(const u32x4*)(bx + row * D);
        const unsigned lw[4] = {lv.x, lv.y, lv.z, lv.w}, bw[4] = {bv.x, bv.y, bv.z, bv.w}; unsigned ow[4];
#pragma unroll
        for (int e = 0; e < 4; ++e) { const float a0 = __expf(bflo(lw[e])), a1 = __expf(bfhi(lw[e]));
            h[2 * e] = a0 * h[2 * e] + bflo(bw[e]); h[2 * e + 1] = a1 * h[2 * e + 1] + bfhi(bw[e]); ow[e] = pk2(h[2 * e], h[2 * e + 1]); }
        *(u32x4*)(hs + row * D) = (u32x4){ow[0], ow[1], ow[2], ow[3]}; }
#undef LRU_ROW
    __syncthreads();
}
__device__ __forceinline__ void attn_unit_latent(Frame& F, int idx) {
    const int qb = idx & 7, g = (idx >> 3) & 3, kvh = (idx >> 5) & 3, b = idx >> 7, h = kvh * 4 + g;
    const size_t r0 = (size_t)b * TT + 256 * qb, k0 = (size_t)b * TT;
    att::attn_dense_body(((bf16*)(F.ws + WS_PROJ)) + r0 * NP + C_AQ + h * 128, ((bf16*)(F.ws + WS_PROJ)) + k0 * NP + C_AK + kvh * 128, ((bf16*)(F.ws + WS_PROJ)) + k0 * NP + C_AV + kvh * 128, ((bf16*)(F.ws + WS_OBR)) + (size_t)M * D + r0 * D + h * 128, TT, (char*)F.lds);
    __syncthreads();
}
__device__ __forceinline__ void attn_unit_ctx(Frame& F, int idx) {
    const int h = idx & 15, b = idx >> 4, kvh = h >> 2; const size_t r0 = (size_t)b * TT + TL;
    att::attn_dense_body(((bf16*)(F.ws + WS_PROJ)) + r0 * NP + C_AQ + h * 128, ((bf16*)(F.ws + WS_PROJ)) + r0 * NP + C_AK + kvh * 128, ((bf16*)(F.ws + WS_PROJ)) + r0 * NP + C_AV + kvh * 128, ((bf16*)(F.ws + WS_OBR)) + (size_t)M * D + r0 * D + h * 128, LC, (char*)F.lds);
    __syncthreads();
}
__device__ __forceinline__ void phase_mix(Frame& F) {
    const int w = F.vcu;
    if (w < 64) { if constexpr (EN(6)) gla_unit(F, w); if constexpr (RP(7)) gla_unit(F, w); return; }
    const int w2 = w - 64, NA = F.G - 64;
    if constexpr (EN(7)) for (int idx = w2; idx < 512; idx += NA) attn_unit_latent(F, idx);
    if constexpr (RP(8)) for (int idx = w2; idx < 512; idx += NA) attn_unit_latent(F, idx);
    { const int nshort = 3 * NA - 512, j = w2 - (NA - nshort);
      if (nshort > 0 && j >= 0) { for (int it = j; it < 128; it += nshort) lru_scan_unit(F, it); for (int it = j; it < 64; it += nshort) attn_unit_ctx(F, it); }
      else if (nshort <= 0) { for (int it = w2; it < 128; it += NA) lru_scan_unit(F, it); for (int it = w2; it < 64; it += NA) attn_unit_ctx(F, it); } }
}

__device__ __forceinline__ void phase_post(Frame& F, int l) {
    refresh(F);
    const int gw = F.vcu * NWAVES + F.wave, NGW = F.G * NWAVES, lane = F.lane;
    f32x4 gn0 = *(const f32x4*)(F.ka->in[I_GNG] + l * 512 + 8 * lane), gn1 = *(const f32x4*)(F.ka->in[I_GNG] + l * 512 + 8 * lane + 4);
    for (int row = gw; row < M; row += NGW) {
#pragma unroll
        for (int hd = 0; hd < 4; ++hd) { const int col = hd * 512 + 8 * lane;
            const u32x4 a = *(const u32x4*)(((bf16*)(F.ws + WS_OF)) + (size_t)row * D + col), bb = *(const u32x4*)(((bf16*)(F.ws + WS_OB)) + (size_t)row * D + col), rr = *(const u32x4*)(((bf16*)(F.ws + WS_PROJ)) + (size_t)row * NP + C_GR + col);
            float o[8] = {bflo(a.x) + bflo(bb.x), bfhi(a.x) + bfhi(bb.x), bflo(a.y) + bflo(bb.y), bfhi(a.y) + bfhi(bb.y), bflo(a.z) + bflo(bb.z), bfhi(a.z) + bfhi(bb.z), bflo(a.w) + bflo(bb.w), bfhi(a.w) + bfhi(bb.w)};
            const float r[8] = {bflo(rr.x), bfhi(rr.x), bflo(rr.y), bfhi(rr.y), bflo(rr.z), bfhi(rr.z), bflo(rr.w), bfhi(rr.w)};
            float ss = 0.f;
#pragma unroll
            for (int e = 0; e < 8; ++e) ss += o[e] * o[e];
            const float rstd = 1.0f / sqrtf(wave_sum(ss) * (1.0f / 512.0f) + EPS);
            const float gn[8] = {gn0.x, gn0.y, gn0.z, gn0.w, gn1.x, gn1.y, gn1.z, gn1.w};
#pragma unroll
            for (int e = 0; e < 8; ++e) o[e] = o[e] * rstd * gn[e] * siluf_(r[e]);
            u32x4 w; w.x = pk2(o[0], o[1]); w.y = pk2(o[2], o[3]); w.z = pk2(o[4], o[5]); w.w = pk2(o[6], o[7]);
            *(u32x4*)(((bf16*)(F.ws + WS_OBR)) + (size_t)row * D + col) = w; }
#pragma unroll
        for (int j = 0; j < 4; ++j) { const int col = j * 512 + 8 * lane;
            const u32x4 a = *(const u32x4*)(((bf16*)(F.ws + WS_HS)) + (size_t)row * D + col), bb = *(const u32x4*)(((bf16*)(F.ws + WS_HS)) + ((size_t)M + row) * D + col), yy = *(const u32x4*)(((bf16*)(F.ws + WS_PROJ)) + (size_t)row * NP + C_LY + col);
            float o[8] = {bflo(a.x) + bflo(bb.x), bfhi(a.x) + bfhi(bb.x), bflo(a.y) + bflo(bb.y), bfhi(a.y) + bfhi(bb.y), bflo(a.z) + bflo(bb.z), bfhi(a.z) + bfhi(bb.z), bflo(a.w) + bflo(bb.w), bfhi(a.w) + bfhi(bb.w)};
            const float y[8] = {bflo(yy.x), bfhi(yy.x), bflo(yy.y), bfhi(yy.y), bflo(yy.z), bfhi(yy.z), bflo(yy.w), bfhi(yy.w)};
#pragma unroll
            for (int e = 0; e < 8; ++e) o[e] *= gelu_tanh(y[e]);
            u32x4 w; w.x = pk2(o[0], o[1]); w.y = pk2(o[2], o[3]); w.z = pk2(o[4], o[5]); w.w = pk2(o[6], o[7]);
            *(u32x4*)(((bf16*)(F.ws + WS_OBR)) + ((size_t)2 * M + row) * D + col) = w; }
    }
}
}

using namespace mk;
constexpr int N_PHASES = 42;
typedef KArgs Args;

__global__ void __launch_bounds__(NTHR, 2) hybrid_fwd(Args args) {
    extern __shared__ __attribute__((aligned(16))) unsigned char lds_raw[];
    Frame F;
    F.lds = (LAS unsigned char*)lds_raw;
    F.tid = threadIdx.x; F.lane = F.tid & 63; F.wave = __builtin_amdgcn_readfirstlane(F.tid >> 6);
    F.G = gridDim.x; { const int bx = blockIdx.x; F.vcu = (F.G % 8 == 0) ? (bx % 8) * (F.G / 8) + bx / 8 : bx; }
    F.ka = &args; F.ws = args.ws;
    unsigned char* ws = args.ws;
    volatile LAS unsigned* MISC = (volatile LAS unsigned*)(F.lds + MISC_OFF);
    if (F.tid < 64) MISC[F.tid] = 0u;
    __syncthreads();
    const int lo = args.ph_lo, hi = args.ph_hi;
    XcdBarrier bar; bar.bar = (unsigned*)(ws + WS_CTL) + CW_BAR; bar.x = 0; bar.st = nullptr;
    if (hi - lo > 1) bar = xcd_barrier_post((unsigned*)(ws + WS_CTL) + CW_BAR, MISC + 8);
#define IN(k) (lo <= (k) && (k) < hi)
#define SEAM(k) do { if (hi > (k) + 1) xcd_barrier(bar); } while (0)
    const int c_id = (int)blockIdx.x;

    if (IN(0)) { if constexpr (EN(0)) phase_prologue(F); if constexpr (RP(0)) { __syncthreads(); phase_prologue(F); } SEAM(0); }
    for (int l = 0; l < DEPTH; ++l) {
        const int pb = 1 + 10 * l;
        const float* modl = ((float*)(F.ws + WS_MOD)) + (size_t)l * 5 * (6 * D);
        if (IN(pb + 0)) { if constexpr (EN(1)) phase_norm(F, l, F.ka->in[I_NMIX] + (size_t)l * D, 0, 1, l > 0); if constexpr (RP(1)) phase_norm(F, l, F.ka->in[I_NMIX] + (size_t)l * D, 0, 1, l > 0); SEAM(pb + 0); }
        if (IN(pb + 1)) {
            pg8::Gemm g{((bf16*)(F.ws + WS_U)), (const bf16*)(ws + WS_WIN + l * WIN_L), M, NINP, D}; pg8::StaticOrder S; S.init(M, NINP, F.G, c_id);
            pg8::EpiProj E{((bf16*)(F.ws + WS_PROJ)), ((float*)(F.ws + WS_DEC))};
            if constexpr (EN(2)) pg8::gemm_phase<pg8::EpiProj, pg8::StaticOrder, true, true>(F.lds, g, S, E);
            if constexpr (RP(2)) pg8::gemm_phase<pg8::EpiProj, pg8::StaticOrder, true, true>(F.lds, g, S, E);
            SEAM(pb + 1); }
        if (IN(pb + 2)) { if constexpr (EN(3)) prep_attn(F, l); if constexpr (EN(4)) prep_gla(F, l); if constexpr (RP(4)) { __syncthreads(); prep_gla(F, l); } __syncthreads(); if constexpr (EN(5)) prep_lru(F, l); if constexpr (RP(5)) { __syncthreads(); prep_lru(F, l); } SEAM(pb + 2); }
        if (IN(pb + 3)) { phase_mix(F); if constexpr (RP(6)) { __syncthreads(); phase_mix(F); } SEAM(pb + 3); }
        if (IN(pb + 4)) { if constexpr (EN(9)) phase_post(F, l); if constexpr (RP(9)) phase_post(F, l); SEAM(pb + 4); }
        if (IN(pb + 5)) {
            pg8::Gemm g{((bf16*)(F.ws + WS_OBR)), (const bf16*)(ws + WS_WBR + l * WBR_L), 3 * M, 3 * D, D}; pg8::BranchOrder S; S.init(F.G, c_id);
            pg8::EpiBranch E{((bf16*)(F.ws + WS_PROJ)), F.ka->in[I_BMERGE] + (size_t)l * 3 * D, ((bf16*)(F.ws + WS_MG))};
            if constexpr (EN(10)) pg8::gemm_phase<pg8::EpiBranch, pg8::BranchOrder, true, true>(F.lds, g, S, E);
            if constexpr (RP(10)) pg8::gemm_phase<pg8::EpiBranch, pg8::BranchOrder, true, true>(F.lds, g, S, E);
            SEAM(pb + 5); }
        if (IN(pb + 6)) {
            pg8::Gemm g{((bf16*)(F.ws + WS_MG)), (const bf16*)(ws + WS_WOUT + l * WOUT_L), M, D, D}; pg8::StaticOrder S; S.init(M, D, F.G, c_id);
            pg8::EpiRes E{((bf16*)(F.ws + WS_Y)), modl + 2 * D};
            if constexpr (EN(11)) pg8::gemm_phase<pg8::EpiRes, pg8::StaticOrder, true, true>(F.lds, g, S, E);
            if constexpr (RP(11)) { pg8::EpiRes E2{((bf16*)(F.ws + WS_Y)), modl + 2 * D}; pg8::gemm_phase<pg8::EpiRes, pg8::StaticOrder, true, true>(F.lds, g, S, E2); }
            SEAM(pb + 6); }
        if (IN(pb + 7)) { phase_norm(F, l, F.ka->in[I_NFFN] + (size_t)l * D, 3, 4, true); SEAM(pb + 7); }
        if (IN(pb + 8)) {
            pg8::Gemm g{((bf16*)(F.ws + WS_U)), (const bf16*)(ws + WS_WF1 + l * WF1_L), M, NF1, D}; pg8::StaticOrder S; S.init(M, NF1, F.G, c_id);
            pg8::EpiSwiglu E{((bf16*)(F.ws + WS_ACT))};
            if constexpr (EN(12)) pg8::gemm_phase<pg8::EpiSwiglu, pg8::StaticOrder, true, true>(F.lds, g, S, E);
            if constexpr (RP(12)) pg8::gemm_phase<pg8::EpiSwiglu, pg8::StaticOrder, true, true>(F.lds, g, S, E);
            SEAM(pb + 8); }
        if (IN(pb + 9)) {
            pg8::Gemm g{((bf16*)(F.ws + WS_ACT)), (const bf16*)(ws + WS_WF2 + l * WF2_L), M, D, FF}; pg8::StaticOrder S; S.init(M, D, F.G, c_id);
            pg8::EpiRes E{((bf16*)(F.ws + WS_Y)), modl + 5 * D};
            if constexpr (EN(13)) pg8::gemm_phase<pg8::EpiRes, pg8::StaticOrder, true, true>(F.lds, g, S, E);
            if constexpr (RP(13)) { pg8::EpiRes E2{((bf16*)(F.ws + WS_Y)), modl + 5 * D}; pg8::gemm_phase<pg8::EpiRes, pg8::StaticOrder, true, true>(F.lds, g, S, E2); }
            SEAM(pb + 9); }
    }
    if (IN(41)) { if constexpr (EN(14)) phase_final(F); }
#undef IN
#undef SEAM
}

#ifndef MK_LAUNCH_PER_PHASE
#define MK_LAUNCH_PER_PHASE 0
#endif
extern "C" void kernel_launch(void* const* d_in, const int* in_sizes, int n_in, void* d_out, int out_size, void* d_ws, size_t ws_size, hipStream_t stream) {
    static int grid = 0;
    if (grid == 0) {
        if (n_in != N_INPUTS || out_size != NB * TL * D || ws_size < WS_END) { fprintf(stderr, "kernel_launch: shape mismatch n_in %d out %d ws %zu (need %zu)\n", n_in, out_size, ws_size, (size_t)WS_END); grid = -1; return; }
        int dev = 0, cus = 0, per_cu = 0;
        if (hipGetDevice(&dev) != hipSuccess || hipDeviceGetAttribute(&cus, hipDeviceAttributeMultiprocessorCount, dev) != hipSuccess) { grid = -1; return; }
        if (hipFuncSetAttribute((const void*)hybrid_fwd, hipFuncAttributeMaxDynamicSharedMemorySize, LDS_BYTES) != hipSuccess) { fprintf(stderr, "kernel_launch: hipFuncSetAttribute failed\n"); grid = -1; return; }
        if (hipOccupancyMaxActiveBlocksPerMultiprocessor(&per_cu, (const void*)hybrid_fwd, NTHR, LDS_BYTES) != hipSuccess || per_cu < 1) fprintf(stderr, "kernel_launch: occupancy query says %d\n", per_cu);
        (void)hipGetLastError();
        grid = cus;
        if (grid != 256) fprintf(stderr, "kernel_launch: %d CUs (built for 256)\n", grid);
    }
    if (grid < 0) return;
    (void)hipMemsetAsync((char*)d_ws + WS_CTL, 0, CTL_ZERO_BYTES, stream);
    Args a{};
    for (int i = 0; i < N_INPUTS; ++i) a.in[i] = (const float*)d_in[i];
    a.out = (float*)d_out; a.ws = (unsigned char*)d_ws;
#if MK_LAUNCH_PER_PHASE
    for (int p = 0; p < N_PHASES; ++p) { a.ph_lo = p; a.ph_hi = p + 1; hipLaunchKernelGGL(hybrid_fwd, dim3(grid), dim3(NTHR), LDS_BYTES, stream, a); }
#else
    a.ph_lo = 0; a.ph_hi = N_PHASES; hipLaunchKernelGGL(hybrid_fwd, dim3(grid), dim3(NTHR), LDS_BYTES, stream, a);
#endif
    const hipError_t le = hipPeekAtLastError();
    if (le != hipSuccess) fprintf(stderr, "kernel_launch: launch failed: %s\n", hipGetErrorName(le));
}
```

```cpp
#include <hip/hip_runtime.h>
#include <hip/hip_bf16.h>
#include <cstdio>
#include <cstdint>
#define LAS __attribute__((address_space(3)))
#define GAS __attribute__((address_space(1)))
namespace pg8 {
#define PG8_LAS __attribute__((address_space(3)))
typedef unsigned short bf16_t;
typedef short bf16x8 __attribute__((ext_vector_type(8)));
typedef float f32x4 __attribute__((ext_vector_type(4)));
typedef unsigned u32x4 __attribute__((ext_vector_type(4)));
constexpr int BM = 256, BK = 64, HALF = 128, HTB = HALF * BK * 2  , STAGE_BYTES = 8 * HTB, NXCD = 8, WGM = 8;

__host__ __device__ __forceinline__ int lds_byte(int r, int c) { const int st = (r >> 4) * 2 + (c >> 5), rr = r & 15, cc = c & 31, ob = rr * 64 + cc * 2; return st * 1024 + (ob ^ (((ob >> 9) & 1) << 5)); }
__host__ __device__ __forceinline__ void stage_rc(int b, int& R, int& C) { const int st = b / 1024, sb = b % 1024, swz = sb ^ (((sb >> 9) & 1) << 5); R = (st >> 1) * 16 + swz / 64; C = (st & 1) * 32 + (swz % 64) / 2; }
__host__ __device__ __forceinline__ int perm32(int rho) { const int n = rho >> 4, i = rho & 15; return 8 * (i >> 2) + 4 * n + (i & 3); }

struct Unit { int pm, pn, k0, nk, aux; };
struct Gemm { const bf16_t* A; const bf16_t* Bt; int M, N, K, ld; };

struct StaticOrder {
    int nM, nN, nwg, G, c, nt, lat;
    __host__ __device__ __forceinline__ void init(int M, int N, int G_, int c_, int nt_, int lat_ = 0) { nM = M / BM; nN = N / BM; nwg = nM * nN; G = G_; c = c_; nt = nt_; lat = lat_; }
    __host__ __device__ __forceinline__ bool next(int i, Unit& u) const {
        const long L = (long)i * G + c; if (L >= nwg) return false;
        int wgid = (int)L; { const int q = nwg / NXCD, r = nwg % NXCD, xcd = wgid % NXCD, off = wgid / NXCD; wgid = (xcd < r ? xcd * (q + 1) : r * (q + 1) + (xcd - r) * q) + off; }
        const int nig = WGM * nN, gid = wgid / nig, fm = gid * WGM, gsz = (nM - fm) < WGM ? (nM - fm) : WGM;
        u.pm = fm + ((wgid % nig) % gsz); u.pn = (wgid % nig) / gsz; u.k0 = 0; u.nk = nt; u.aux = -1; if (lat) u.pm = 9 * (u.pm >> 3) + (u.pm & 7); return true;
    }
    __device__ __forceinline__ void a_ready(const Unit&) const {}
    __device__ __forceinline__ void done(const Unit&) const {}
};

__device__ __forceinline__ unsigned cvt_pk_bf16(float lo, float hi) { unsigned r; asm volatile("v_cvt_pk_bf16_f32 %0, %1, %2" : "=v"(r) : "v"(lo), "v"(hi)); return r; }
template <class Epi, class Sched, bool ALIGN_EPI = false, bool SP2 = false>
__device__ __forceinline__ void gemm_phase(PG8_LAS unsigned char* lds, const Gemm g, const Sched& S, const Epi& E) {
    int tid_ = threadIdx.x; asm volatile("" : "+v"(tid_));
    const int tid = tid_, wid = __builtin_amdgcn_readfirstlane(tid >> 6), lane = tid & 63, wr = wid >> 2, wc = wid & 3, fr = lane & 15, fq = lane >> 4;
    const int LD = g.ld;
    unsigned voffA[2], voffB[2];
#pragma unroll
    for (int i = 0; i < 2; ++i) { int R, C; stage_rc(tid * 16 + i * 8192, R, C); const int Rb = Epi::PERM ? ((R & ~31) + perm32(R & 31)) : R;
        voffA[i] = (unsigned)(R * LD + C) * 2u; voffB[i] = (unsigned)(Rb * LD + C) * 2u; }
    const size_t kstep = (size_t)(BK * 2);
    const size_t hstep = (size_t)HALF * LD * 2;
    const size_t tstep = 2 * hstep;
    const unsigned ldsw = (unsigned)wid * 1024u;
    const int aoff = lds_byte(wr * 64 + fr, fq * 8), boff = lds_byte(wc * 32 + fr, fq * 8);
#define PG8_SA(b, h) (((b) * 2 + (h)) * HTB)
#define PG8_SB(b, h) ((4 + (b) * 2 + (h)) * HTB)
#define PG8_STAGE(bufoff, gbase, voff) do { _Pragma("unroll") for (int _i = 0; _i < 2; ++_i) \
        __builtin_amdgcn_global_load_lds((const unsigned*)((const char*)(gbase) + (voff)[_i]), (PG8_LAS unsigned*)(lds + (bufoff) + ldsw + _i * 8192), 16, 0, 0); } while (0)
#define PG8_LDA(dst, b, h) do { _Pragma("unroll") for (int m = 0; m < 4; ++m) _Pragma("unroll") for (int k = 0; k < 2; ++k) dst[m][k] = *(const PG8_LAS bf16x8*)(lds + PG8_SA(b, h) + aoff + m * 2048 + k * 1024); } while (0)
#define PG8_LDB(dst, b, h) do { _Pragma("unroll") for (int n = 0; n < 2; ++n) _Pragma("unroll") for (int k = 0; k < 2; ++k) dst[n][k] = *(const PG8_LAS bf16x8*)(lds + PG8_SB(b, h) + boff + n * 2048 + k * 1024); } while (0)
#define PG8_MMA(ai, bj, At, Bt) do { __builtin_amdgcn_s_setprio(1); _Pragma("unroll") for (int m = 0; m < 4; ++m) _Pragma("unroll") for (int n = 0; n < 2; ++n) _Pragma("unroll") for (int k = 0; k < 2; ++k) \
        acc[ai][bj][m][n] = __builtin_amdgcn_mfma_f32_16x16x32_bf16(Bt[n][k], At[m][k], acc[ai][bj][m][n], 0, 0, 0); __builtin_amdgcn_s_setprio(0); } while (0)
#define PG8_WAIT_V(n) asm volatile("s_waitcnt vmcnt(" #n ")" ::: "memory")
#define PG8_WAIT_L(n) asm volatile("s_waitcnt lgkmcnt(" #n ")" ::: "memory")
#define PG8_BAR __builtin_amdgcn_s_barrier()
#define PG8_SCHED __builtin_amdgcn_sched_barrier(0)
    Unit cur, nxt; int ui = 0;
    if (!S.next(0, cur)) return;
    f32x4 acc[2][2][4][2];
#pragma unroll
    for (int a = 0; a < 2; ++a)
#pragma unroll
        for (int b = 0; b < 2; ++b)
#pragma unroll
            for (int m = 0; m < 4; ++m)
#pragma unroll
                for (int n = 0; n < 2; ++n) acc[a][b][m][n] = (f32x4){0.f, 0.f, 0.f, 0.f};
    bf16x8 At[4][2], B0[2][2], B1[2][2];
    const char* cA = (const char*)g.A + (size_t)cur.pm * tstep + (size_t)cur.k0 * kstep; const char* cB = (const char*)g.Bt + (size_t)cur.pn * tstep + (size_t)cur.k0 * kstep;
    S.a_ready(cur);
    if constexpr (SP2) {
        PG8_STAGE(PG8_SB(0, 0), cB, voffB); PG8_STAGE(PG8_SB(0, 1), cB + hstep, voffB); PG8_STAGE(PG8_SA(0, 0), cA, voffA); PG8_STAGE(PG8_SA(0, 1), cA + hstep, voffA);
        if (wr == 1) PG8_BAR;
        PG8_WAIT_V(2); PG8_BAR;
        PG8_STAGE(PG8_SB(1, 0), cB + kstep, voffB); PG8_STAGE(PG8_SA(1, 0), cA + kstep, voffA); PG8_STAGE(PG8_SB(1, 1), cB + hstep + kstep, voffB);
        PG8_WAIT_V(6); PG8_BAR;
    } else {
        PG8_STAGE(PG8_SB(0, 0), cB, voffB); PG8_STAGE(PG8_SA(0, 0), cA, voffA); PG8_STAGE(PG8_SB(0, 1), cB + hstep, voffB); PG8_STAGE(PG8_SA(0, 1), cA + hstep, voffA);
        if (wr == 1) PG8_BAR;
        PG8_WAIT_V(4); PG8_BAR;
        PG8_STAGE(PG8_SB(1, 0), cB + kstep, voffB); PG8_STAGE(PG8_SA(1, 0), cA + kstep, voffA); PG8_STAGE(PG8_SB(1, 1), cB + hstep + kstep, voffB);
        PG8_WAIT_V(6); PG8_BAR;
    }
    for (;;) {
        const bool has_next = S.next(ui + 1, nxt);
        const char* nA = has_next ? (const char*)g.A + (size_t)nxt.pm * tstep + (size_t)nxt.k0 * kstep : cA; const char* nB = has_next ? (const char*)g.Bt + (size_t)nxt.pn * tstep + (size_t)nxt.k0 * kstep : cB;
        const int nt = cur.nk;
        for (int t = 0; t < nt; t += 2) {
            const bool last = (t == nt - 2);
            const char* a1 = cA + (size_t)(t + 1) * kstep;
            const char* a2 = last ? nA : cA + (size_t)(t + 2) * kstep; const char* b2 = last ? nB : cB + (size_t)(t + 2) * kstep;
            const char* a3 = a2 + kstep; const char* b3 = b2 + kstep;
            if (last && has_next) S.a_ready(nxt);
            if constexpr (SP2) {
            PG8_LDB(B0, 0, 0); PG8_LDB(B1, 0, 1); PG8_SCHED; PG8_LDA(At, 0, 0); PG8_STAGE(PG8_SA(1, 1), a1 + hstep, voffA);
            PG8_WAIT_V(8); PG8_WAIT_L(0); PG8_BAR; PG8_MMA(0, 0, At, B0); PG8_MMA(0, 1, At, B1); PG8_BAR; PG8_SCHED;
            PG8_LDA(At, 0, 1); PG8_STAGE(PG8_SB(0, 0), b2, voffB); PG8_STAGE(PG8_SB(0, 1), b2 + hstep, voffB); PG8_STAGE(PG8_SA(0, 0), a2, voffA);
            PG8_WAIT_V(8); PG8_WAIT_L(0); PG8_BAR; PG8_MMA(1, 0, At, B0); PG8_MMA(1, 1, At, B1); PG8_BAR; PG8_SCHED;
            PG8_LDB(B0, 1, 0); PG8_LDB(B1, 1, 1); PG8_SCHED; PG8_LDA(At, 1, 0); PG8_STAGE(PG8_SA(0, 1), a2 + hstep, voffA);
            PG8_WAIT_V(8); PG8_WAIT_L(0); PG8_BAR; PG8_MMA(0, 0, At, B0); PG8_MMA(0, 1, At, B1); PG8_BAR; PG8_SCHED;
            PG8_LDA(At, 1, 1); PG8_STAGE(PG8_SB(1, 0), b3, voffB); PG8_STAGE(PG8_SB(1, 1), b3 + hstep, voffB); PG8_STAGE(PG8_SA(1, 0), a3, voffA);
            PG8_WAIT_V(8); PG8_WAIT_L(0); PG8_BAR; PG8_MMA(1, 0, At, B0); PG8_MMA(1, 1, At, B1); PG8_BAR; PG8_SCHED;
            } else {
            PG8_LDB(B0, 0, 0); PG8_SCHED; PG8_LDA(At, 0, 0); PG8_STAGE(PG8_SA(1, 1), a1 + hstep, voffA);
            PG8_WAIT_L(8); PG8_BAR; PG8_WAIT_L(0); PG8_MMA(0, 0, At, B0); PG8_BAR; PG8_SCHED;
            PG8_LDB(B1, 0, 1); PG8_STAGE(PG8_SB(0, 0), b2, voffB);
            PG8_BAR; PG8_WAIT_L(0); PG8_MMA(0, 1, At, B1); PG8_BAR;
            PG8_LDA(At, 0, 1); PG8_STAGE(PG8_SA(0, 0), a2, voffA);
            PG8_BAR; PG8_WAIT_L(0); PG8_MMA(1, 0, At, B0); PG8_BAR; PG8_SCHED;
            PG8_STAGE(PG8_SB(0, 1), b2 + hstep, voffB);
            PG8_WAIT_V(6); PG8_BAR; PG8_MMA(1, 1, At, B1); PG8_BAR;
            PG8_LDB(B0, 1, 0); PG8_SCHED; PG8_LDA(At, 1, 0); PG8_STAGE(PG8_SA(0, 1), a2 + hstep, voffA);
            PG8_WAIT_L(8); PG8_BAR; PG8_WAIT_L(0); PG8_MMA(0, 0, At, B0); PG8_BAR; PG8_SCHED;
            PG8_LDB(B1, 1, 1); PG8_STAGE(PG8_SB(1, 0), b3, voffB);
            PG8_BAR; PG8_WAIT_L(0); PG8_MMA(0, 1, At, B1); PG8_BAR;
            PG8_LDA(At, 1, 1); PG8_STAGE(PG8_SA(1, 0), a3, voffA);
            PG8_BAR; PG8_WAIT_L(0); PG8_MMA(1, 0, At, B0); PG8_BAR; PG8_SCHED;
            PG8_STAGE(PG8_SB(1, 1), b3 + hstep, voffB);
            PG8_WAIT_V(6); PG8_BAR; PG8_MMA(1, 1, At, B1); PG8_BAR;
            }
        }
        if constexpr (ALIGN_EPI) { if (wr == 0) PG8_BAR; }
        if constexpr (!Epi::AFTER_DRAIN) { E(acc, cur, wr, wc, fr, fq); S.done(cur); }
        if (!has_next) break;
        if (!E.keep(cur)) {
#pragma unroll
        for (int a = 0; a < 2; ++a)
#pragma unroll
            for (int b = 0; b < 2; ++b)
#pragma unroll
                for (int m = 0; m < 4; ++m)
#pragma unroll
                    for (int n = 0; n < 2; ++n) acc[a][b][m][n] = (f32x4){0.f, 0.f, 0.f, 0.f};
        }
        cur = nxt; cA = nA; cB = nB; ++ui;
        if constexpr (ALIGN_EPI) { if (wr == 1) PG8_BAR; }
    }
    PG8_WAIT_V(0);
    if constexpr (!ALIGN_EPI) { if (wr == 0) PG8_BAR; }
    PG8_BAR;
    if constexpr (Epi::AFTER_DRAIN) { E.fused(acc, cur, wr, wc, fr, fq, lds, wid, lane); S.done(cur); }
#undef PG8_SA
#undef PG8_SB
#undef PG8_STAGE
#undef PG8_LDA
#undef PG8_LDB
#undef PG8_MMA
#undef PG8_WAIT_V
#undef PG8_WAIT_L
#undef PG8_BAR
#undef PG8_SCHED
}
}
#define XB_TMO      128
#define XB_XCNT(j)  (256  + 64 * (j))
#define XB_XSUB(j)  (1280 + 64 * (j))
#define XB_XGEN(j)  (2304 + 64 * (j))
#define XB_TOP      3328
#define XB_TOPGEN   3392
#define XCD_BAR_WORDS 3456
#define XB_SPIN_CAP (1u << 18)

__device__ __forceinline__ unsigned xb_ld(unsigned* p)              { return __hip_atomic_load(p, __ATOMIC_RELAXED, __HIP_MEMORY_SCOPE_AGENT); }
__device__ __forceinline__ unsigned xb_add(unsigned* p, unsigned v) { return __hip_atomic_fetch_add(p, v, __ATOMIC_RELAXED, __HIP_MEMORY_SCOPE_AGENT); }
__device__ __forceinline__ unsigned xb_xcc_id() { return (unsigned)__builtin_amdgcn_s_getreg((3 << 11) | 20) & 0xFu; }
#define XB_SPIN(cond, bar) do { unsigned _sp = 0; while (cond) { __builtin_amdgcn_s_sleep(1); \
    if ((++_sp & 255u) == 0u) { if (xb_ld(&(bar)[XB_TMO])) break; if (_sp > XB_SPIN_CAP) { atomicAdd(&(bar)[XB_TMO], 1u); break; } } } } while (0)

struct XcdBarrier {
    unsigned* bar; unsigned x;
    volatile LAS unsigned* st;
};

__device__ __forceinline__ XcdBarrier xcd_barrier_post(unsigned* bar, volatile LAS unsigned* st) {
    XcdBarrier b; b.bar = bar; b.x = xb_xcc_id(); b.st = st;
    if (threadIdx.x == 0) (void)xb_add(&bar[XB_XCNT(b.x)], 1u);
    return b;
}
__device__ __forceinline__ void xcd_barrier_complete(unsigned* bar, unsigned x, unsigned& nloc, unsigned& nx) {
    const unsigned G = gridDim.x * gridDim.y * gridDim.z;
    unsigned sum, cnt, mine, sp = 0u;
    for (;;) {
        sum = 0u; cnt = 0u; mine = 0u;
#pragma unroll
        for (unsigned j = 0; j < 16; ++j) { const unsigned c = xb_ld(&bar[XB_XCNT(j)]); sum += c; cnt += (c > 0u) ? 1u : 0u; mine = (j == x) ? c : mine; }
        if (sum == G) break;
        __builtin_amdgcn_s_sleep(1);
        if ((++sp & 255u) == 0u) { if (xb_ld(&bar[XB_TMO])) break; if (sp > XB_SPIN_CAP) { atomicAdd(&bar[XB_TMO], 1u); break; } }
    }
    nloc = mine > 0u ? mine : 1u; nx = cnt > 0u ? cnt : 1u;
}

__device__ __forceinline__ void xcd_barrier(const XcdBarrier& b) {
    asm volatile("s_waitcnt vmcnt(0)" ::: "memory");
    __syncthreads();
    if (threadIdx.x == 0) {
        unsigned* bar = b.bar;
        __builtin_amdgcn_s_waitcnt(0);
        unsigned nloc = b.st[0], nx = b.st[1];
        if (nloc == 0u) { xcd_barrier_complete(bar, b.x, nloc, nx); b.st[0] = nloc; b.st[1] = nx; }
        const unsigned old = xb_add(&bar[XB_XSUB(b.x)], 1u);
        const unsigned gen = old / nloc;
        if (old + 1u == (gen + 1u) * nloc) {
            __builtin_amdgcn_fence(__ATOMIC_RELEASE, "agent");
            asm volatile("s_waitcnt vmcnt(0)" ::: "memory");
            const unsigned og = xb_add(&bar[XB_TOP], 1u);
            const unsigned tg = og / nx;
            if (og + 1u == (tg + 1u) * nx) xb_add(&bar[XB_TOPGEN], 1u);
            else XB_SPIN(xb_ld(&bar[XB_TOPGEN]) == tg, bar);
            __builtin_amdgcn_fence(__ATOMIC_ACQUIRE, "agent");
            xb_add(&bar[XB_XGEN(b.x)], 1u);
            asm volatile("s_waitcnt vmcnt(0)" ::: "memory");
        } else {
            XB_SPIN(xb_ld(&bar[XB_XGEN(b.x)]) == gen, bar);
            __builtin_amdgcn_fence(__ATOMIC_ACQUIRE, "agent");
            asm volatile("s_waitcnt vmcnt(0)" ::: "memory");
        }
    }
    __syncthreads();
}
#ifndef PH_MASK
#define PH_MASK 0xFFFFFFFFu
#endif
#define EN(k) (((PH_MASK) >> (k)) & 1u)
#ifndef REP_MASK
#define REP_MASK 0u
#endif
#define RP(k) (((REP_MASK) >> (k)) & 1u)
namespace mk {
typedef unsigned short bf16;
typedef short bf16x8 __attribute__((ext_vector_type(8)));
typedef short s16x4 __attribute__((ext_vector_type(4)));
typedef float f32x2 __attribute__((ext_vector_type(2)));
typedef float f32x4 __attribute__((ext_vector_type(4)));
typedef float f32x16 __attribute__((ext_vector_type(16)));
typedef unsigned u32x2 __attribute__((ext_vector_type(2)));
typedef unsigned u32x4 __attribute__((ext_vector_type(4)));

constexpr int D = 2048, NB = 4, TL = 2048, LC = 256, TT = 2304, M = NB * TT, DEPTH = 4;
constexpr int NIN = 19488, NP = 19456, NINP = 19712, FF = 5632, NF1 = 11264, KP = 2112;
constexpr int C_GQ = 0, C_GK = 1024, C_GV = 2048, C_GR = 4096, C_AQ = 6144, C_AK = 8192, C_AV = 8704, C_LX = 9216, C_LY = 11264, C_GATE = 13312;
constexpr float EPS = 1e-6f;
constexpr int NWAVES = 8, NTHR = 512;

enum { I_X = 0, I_C, I_CTX, I_CCTX, I_WMOD, I_BMOD, I_NMIX, I_NFFN, I_WIN, I_GWD, I_GBD, I_GNG, I_QNG, I_KNG, I_CW, I_CB, I_LWA, I_LBA, I_LWI, I_LBI, I_LAM, I_BMERGE, I_WBR, I_WOUT,
       I_WF1, I_WF2, I_FNG, N_INPUTS };

constexpr size_t MiB = 1u << 20;
constexpr size_t WS_CTL = 0, CTL_ZERO_BYTES = 1 * MiB;
constexpr size_t WS_MOD = 1 * MiB, WS_ROPE = 2 * MiB, WS_DEC = 4 * MiB, WS_DL = 6 * MiB, WS_WL = 8 * MiB;
constexpr size_t WS_WIN = 16 * MiB, WIN_L = 80 * MiB;
constexpr size_t WS_WBR = 336 * MiB, WBR_L = 25 * MiB;
constexpr size_t WS_WOUT = 436 * MiB, WOUT_L = 9 * MiB;
constexpr size_t WS_WF1 = 472 * MiB, WF1_L = 46 * MiB;
constexpr size_t WS_WF2 = 656 * MiB, WF2_L = 22 * MiB;
constexpr size_t WS_H = 744 * MiB, WS_U = 816 * MiB  , WS_PROJ = 854 * MiB;
constexpr size_t WS_QD = 1196 * MiB, QD_ONE = 18 * MiB;
constexpr size_t WS_OF = 1304 * MiB, WS_OB = 1340 * MiB;
constexpr size_t WS_LA = 1376 * MiB, ACT36 = 36 * MiB;
constexpr size_t WS_HS = 1520 * MiB;
constexpr size_t WS_OBR = 1592 * MiB;
constexpr size_t WS_MF = 1704 * MiB, WS_Y = WS_MF, WS_MG = 1776 * MiB  , WS_ACT = 1814 * MiB, WS_SLAB = 1913 * MiB  , WS_END = 1977 * MiB;
static_assert((size_t)NINP * KP * 2 <= WIN_L && (size_t)6144 * KP * 2 <= WBR_L && (size_t)2048 * KP * 2 <= WOUT_L && (size_t)NF1 * KP * 2 <= WF1_L && (size_t)M * KP * 2 <= 38 * MiB && (size_t)3 * M * KP * 2 <= 112 * MiB, "ws map (padded)");
static_assert((size_t)M * NP * 2 == 342 * MiB && (size_t)M * D * 4 == 72 * MiB && (size_t)M * FF * 2 == 99 * MiB, "ws map");
constexpr int CW_BAR = 4096;

constexpr int LDS_MAIN = 155648, MISC_OFF = LDS_MAIN, LDS_BYTES = LDS_MAIN + 256;

__device__ __forceinline__ float bf2f(unsigned v) { return __uint_as_float(v << 16); }
__device__ __forceinline__ float bflo(unsigned v) { return __uint_as_float(v << 16); }
__device__ __forceinline__ float bfhi(unsigned v) { return __uint_as_float(v & 0xffff0000u); }
typedef __bf16 bf16x2_t __attribute__((ext_vector_type(2)));
__device__ __forceinline__ unsigned pk2(float lo, float hi) { f32x2 v = {lo, hi}; bf16x2_t b = __builtin_convertvector(v, bf16x2_t); return __builtin_bit_cast(unsigned, b); }
__device__ __forceinline__ bf16 f2bf(float f) { return (bf16)(pk2(f, 0.f) & 0xffffu); }
__device__ __forceinline__ float wave_sum(float v) {
#pragma unroll
    for (int o = 1; o < 64; o <<= 1) v += __shfl_xor(v, o);
    return v;
}
__device__ __forceinline__ float sigmoidf_(float x) { return 1.0f / (1.0f + __expf(-x)); }
__device__ __forceinline__ float siluf_(float x) { return x / (1.0f + __expf(-x)); }
__device__ __forceinline__ float gelu_tanh(float x) { const float u = 1.5957691216f * (x + 0.044715f * x * x * x); return x / (1.0f + __expf(-u)); }
__device__ __forceinline__ int crow(int r, int hi) { return (r & 3) + 8 * (r >> 2) + 4 * hi; }
#define MFMA32(a, b, c) __builtin_amdgcn_mfma_f32_32x32x16_bf16((a), (b), (c), 0, 0, 0)
#define MFMA16(a, b, c) __builtin_amdgcn_mfma_f32_16x16x32_bf16((a), (b), (c), 0, 0, 0)
typedef short v4i16_t __attribute__((ext_vector_type(4)));
__device__ __forceinline__ s16x4 vtr(LAS unsigned char* p) { return __builtin_bit_cast(s16x4, __builtin_amdgcn_ds_read_tr16_b64_v4i16((LAS v4i16_t*)p)); }
__device__ __forceinline__ bf16x8 cat8(s16x4 lo, s16x4 hi) { return __builtin_shufflevector(lo, hi, 0, 1, 2, 3, 4, 5, 6, 7); }

struct KArgs { const float* in[N_INPUTS]; float* out; unsigned char* ws; int ph_lo, ph_hi; };
struct Frame {
    LAS unsigned char* lds;
    int tid, lane, wave, vcu, G;
    const KArgs* ka;
    unsigned char* ws;
};
__device__ __forceinline__ void refresh(Frame& F) { int t = threadIdx.x; asm volatile("" : "+v"(t)); F.tid = t; F.lane = t & 63; F.wave = __builtin_amdgcn_readfirstlane(t >> 6); }
}

namespace pg8 {
__device__ __forceinline__ float ep_sigmoid(float x) { return 1.0f / (1.0f + __expf(-x)); }
struct EpiProj {
    static constexpr bool PERM = true, AFTER_DRAIN = false;
    bf16_t* P; float* DEC;
    __device__ __forceinline__ bool keep(const Unit&) const { return false; }
    __device__ __forceinline__ void operator()(const f32x4 (&acc)[2][2][4][2], const Unit& u, int wr, int wc, int fr, int fq) const {
        const int row0 = u.pm * BM + wr * 64 + fr;
        if (u.pn < 76) {
            const int col0 = u.pn * BM + wc * 32 + 8 * fq;
#pragma unroll
            for (int ai = 0; ai < 2; ++ai)
#pragma unroll
                for (int m = 0; m < 4; ++m) { bf16_t* rowp = P + (size_t)(row0 + ai * HALF + m * 16) * mk::NP + col0;
#pragma unroll
                    for (int bj = 0; bj < 2; ++bj) { const f32x4 v0 = acc[ai][bj][m][0], v1 = acc[ai][bj][m][1];
                        u32x4 w; w.x = cvt_pk_bf16(v0[0], v0[1]); w.y = cvt_pk_bf16(v0[2], v0[3]); w.z = cvt_pk_bf16(v1[0], v1[1]); w.w = cvt_pk_bf16(v1[2], v1[3]);
                        *(u32x4*)(rowp + bj * HALF) = w; } }
        } else if (wc == 0) {
#pragma unroll
            for (int ai = 0; ai < 2; ++ai)
#pragma unroll
                for (int m = 0; m < 4; ++m) { float* rp = DEC + (size_t)(row0 + ai * HALF + m * 16) * 32 + 8 * fq;
                    *(f32x4*)rp = acc[ai][0][m][0]; *(f32x4*)(rp + 4) = acc[ai][0][m][1]; }
        }
    }
};
struct EpiBranch {
    static constexpr bool PERM = true, AFTER_DRAIN = false;
    const bf16_t* P; const float* bmerge; bf16_t* MG;
    __device__ __forceinline__ bool keep(const Unit& u) const { return (u.pn >> 3) < 2; }
    static __device__ __forceinline__ void unpack8(const u32x4 g, const f32x4 b0, const f32x4 b1, float (&x)[8]) {
        x[0] = __uint_as_float(g.x << 16) + b0[0]; x[1] = __uint_as_float(g.x & 0xffff0000u) + b0[1]; x[2] = __uint_as_float(g.y << 16) + b0[2]; x[3] = __uint_as_float(g.y & 0xffff0000u) + b0[3];
        x[4] = __uint_as_float(g.z << 16) + b1[0]; x[5] = __uint_as_float(g.z & 0xffff0000u) + b1[1]; x[6] = __uint_as_float(g.w << 16) + b1[2]; x[7] = __uint_as_float(g.w & 0xffff0000u) + b1[3]; }
    __device__ __forceinline__ void operator()(f32x4 (&acc)[2][2][4][2], const Unit& u, int wr, int wc, int fr, int fq) const {
        const int n = u.pn >> 3, pn = u.pn & 7, pm = u.pm - 36 * n, n1 = n < 2 ? n + 1 : 2;
        const int col0 = pn * BM + wc * 32 + 8 * fq;
        const bf16_t* ga = P + (size_t)pm * BM * mk::NP + mk::C_GATE + n * 2048; const bf16_t* gb = P + (size_t)pm * BM * mk::NP + mk::C_GATE + n1 * 2048;
        const float* ba = bmerge + n * 2048; const float* bb = bmerge + n1 * 2048;
        const unsigned goff = (unsigned)((wr * 64 + fr) * mk::NP + col0);
#pragma unroll
        for (int ai = 0; ai < 2; ++ai)
#pragma unroll
            for (int m = 0; m < 4; ++m) { const unsigned go = goff + (unsigned)((ai * HALF + m * 16) * mk::NP);
#pragma unroll
                for (int bj = 0; bj < 2; ++bj) { float xa[8], xb[8];
                    unpack8(*(const u32x4*)(ga + go + bj * HALF), *(const f32x4*)(ba + col0 + bj * HALF), *(const f32x4*)(ba + col0 + bj * HALF + 4), xa);
                    unpack8(*(const u32x4*)(gb + go + bj * HALF), *(const f32x4*)(bb + col0 + bj * HALF), *(const f32x4*)(bb + col0 + bj * HALF + 4), xb);
#pragma unroll
                    for (int e = 0; e < 8; ++e) { const float num = n < 2 ? 1.0f + __expf(-xb[e]) : 1.0f; xa[e] = num * __builtin_amdgcn_rcpf(1.0f + __expf(-xa[e])); }
#pragma unroll
                    for (int e = 0; e < 4; ++e) { acc[ai][bj][m][0][e] *= xa[e]; acc[ai][bj][m][1][e] *= xa[4 + e]; } }
                if (m & 1) asm volatile("" ::: "memory"); }
        if (n == 2) { bf16_t* ob = MG + (size_t)pm * BM * mk::KP; const unsigned ooff = (unsigned)((wr * 64 + fr) * mk::KP + col0);
#pragma unroll
            for (int ai = 0; ai < 2; ++ai)
#pragma unroll
                for (int m = 0; m < 4; ++m) { const unsigned oo = ooff + (unsigned)((ai * HALF + m * 16) * mk::KP);
#pragma unroll
                    for (int bj = 0; bj < 2; ++bj) { const f32x4 v0 = acc[ai][bj][m][0], v1 = acc[ai][bj][m][1];
                        u32x4 w; w.x = cvt_pk_bf16(v0[0], v0[1]); w.y = cvt_pk_bf16(v0[2], v0[3]); w.z = cvt_pk_bf16(v1[0], v1[1]); w.w = cvt_pk_bf16(v1[2], v1[3]);
                        *(u32x4*)(ob + oo + bj * HALF) = w; } } }
    }
};
struct EpiRes {
    static constexpr bool PERM = true, AFTER_DRAIN = false;
    bf16_t* Y; const float* gate; float* SLAB;
    __device__ __forceinline__ bool keep(const Unit&) const { return false; }
    __device__ __forceinline__ void operator()(const f32x4 (&acc)[2][2][4][2], const Unit& u, int wr, int wc, int fr, int fq) const {
        const int b = u.pm / 9, rt = (u.pm - 9 * b) < 8 ? b : 4;
        const int col0 = u.pn * BM + wc * 32 + 8 * fq;
        const float* gp = gate + rt * 12288 + col0;
        if (u.aux < 0) { bf16_t* yb = Y + (size_t)u.pm * BM * 2048; const unsigned yo = (unsigned)((wr * 64 + fr) * 2048 + col0);
#pragma unroll
            for (int bj = 0; bj < 2; ++bj) { const f32x4 g0 = *(const f32x4*)(gp + bj * HALF), g1 = *(const f32x4*)(gp + bj * HALF + 4);
#pragma unroll
                for (int ai = 0; ai < 2; ++ai)
#pragma unroll
                    for (int m = 0; m < 4; ++m) { const f32x4 v0 = acc[ai][bj][m][0] * g0, v1 = acc[ai][bj][m][1] * g1;
                        u32x4 w; w.x = cvt_pk_bf16(v0[0], v0[1]); w.y = cvt_pk_bf16(v0[2], v0[3]); w.z = cvt_pk_bf16(v1[0], v1[1]); w.w = cvt_pk_bf16(v1[2], v1[3]);
                        *(u32x4*)(yb + yo + (unsigned)((ai * HALF + m * 16) * 2048 + bj * HALF)) = w; } }
        } else { float* sb = SLAB + ((size_t)u.aux * 1024 + b * 256) * 2048; const unsigned so_ = (unsigned)((wr * 64 + fr) * 2048 + col0);
#pragma unroll
            for (int bj = 0; bj < 2; ++bj) { const f32x4 g0 = *(const f32x4*)(gp + bj * HALF), g1 = *(const f32x4*)(gp + bj * HALF + 4);
#pragma unroll
                for (int ai = 0; ai < 2; ++ai)
#pragma unroll
                    for (int m = 0; m < 4; ++m) { float* rp = sb + so_ + (unsigned)((ai * HALF + m * 16) * 2048 + bj * HALF);
                        *(f32x4*)rp = acc[ai][bj][m][0] * g0; *(f32x4*)(rp + 4) = acc[ai][bj][m][1] * g1; } }
        }
    }
};
struct EpiSwiglu {
    static constexpr bool PERM = true, AFTER_DRAIN = false;
    bf16_t* ACT;
    __device__ __forceinline__ bool keep(const Unit&) const { return false; }
    __device__ __forceinline__ void operator()(const f32x4 (&acc)[2][2][4][2], const Unit& u, int wr, int wc, int fr, int fq) const {
        const int row0 = u.pm * BM + wr * 64 + fr, col0 = u.pn * HALF + wc * 32 + 8 * fq;
#pragma unroll
        for (int ai = 0; ai < 2; ++ai)
#pragma unroll
            for (int m = 0; m < 4; ++m) { float v[8];
#pragma unroll
                for (int n = 0; n < 2; ++n)
#pragma unroll
                    for (int e = 0; e < 4; ++e) { const float g = acc[ai][0][m][n][e], up = acc[ai][1][m][n][e]; v[4 * n + e] = g / (1.0f + __expf(-g)) * up; }
                u32x4 w; w.x = cvt_pk_bf16(v[0], v[1]); w.y = cvt_pk_bf16(v[2], v[3]); w.z = cvt_pk_bf16(v[4], v[5]); w.w = cvt_pk_bf16(v[6], v[7]);
                *(u32x4*)(ACT + (size_t)(row0 + ai * HALF + m * 16) * mk::FF + col0) = w; }
    }
};
struct EpiNull { static constexpr bool PERM = true, AFTER_DRAIN = false; float* sink;
    __device__ __forceinline__ bool keep(const Unit&) const { return false; }
    __device__ __forceinline__ void operator()(const f32x4 (&acc)[2][2][4][2], const Unit& u, int wr, int wc, int fr, int fq) const { f32x4 t = {0.f, 0.f, 0.f, 0.f};
#pragma unroll
        for (int a = 0; a < 2; ++a)
#pragma unroll
            for (int b = 0; b < 2; ++b)
#pragma unroll
                for (int m = 0; m < 4; ++m) { t += acc[a][b][m][0]; t += acc[a][b][m][1]; }
        if (t[0] + t[1] + t[2] + t[3] == 1.2345e-30f) sink[0] = 1.f; } };
struct BranchOrder {
    StaticOrder so;
    __device__ __forceinline__ void init(int G, int c, int lat) { so.init(lat ? 8192 : mk::M, 2048, G, c, 32, lat); }
    __device__ __forceinline__ bool next(int i, Unit& u) const { const int it = i / 3, n = i - 3 * it; if (!so.next(it, u)) return false; u.pm += 36 * n; u.pn += 8 * n; return true; }
    __device__ __forceinline__ void a_ready(const Unit&) const {}
    __device__ __forceinline__ void done(const Unit&) const {}
};
struct ResOrder {
    int G, c, nt, lat;
    __device__ __forceinline__ void init(int G_, int c_, int nt_, int lat_) { G = G_; c = c_; nt = nt_; lat = lat_; }
    __device__ __forceinline__ bool next(int i, Unit& u) const {
        int L = i * G + c + (lat ? 256 : 0); if (L >= 512) return false;
        const bool piece = L < 256; const int ct = L >> 3, j = L & 7, t = L - 256, lp = t >> 3;
        const int pk0 = nt == 32 ? 4 * j : (j < 4 ? 12 * j : 48 + 10 * (j - 4)), pnk = nt == 32 ? 4 : (j < 4 ? 12 : 10);
        u.pm = piece ? 9 * (ct >> 3) + 8 : 9 * (lp >> 3) + (lp & 7); u.pn = piece ? (ct & 7) : (t & 7); u.aux = piece ? j : -1; u.k0 = piece ? pk0 : 0; u.nk = piece ? pnk : nt;
        return true; }
    __device__ __forceinline__ void a_ready(const Unit&) const {}
    __device__ __forceinline__ void done(const Unit&) const {}
};
}

namespace att {
using namespace mk;
constexpr int DH = 128, NW = 8, QBLK = 32, KVBLK = 64;
constexpr float SCALE = 0.088388347648318440f;
constexpr float THR = 8.f;
constexpr int LDQ = NP, LDK = NP, LDO = KP;
constexpr int SHM_V = KVBLK * DH * 2, SHM_K = KVBLK * DH * 2, SHM_ATTN = 2 * SHM_V + 2 * SHM_K + NW * 64 * 4;
#define KSWZ(row, colB) ((row) * 256 + ((colB) ^ (((row) & 7) << 4)))
#define SBAR() __builtin_amdgcn_sched_barrier(0)
__device__ __forceinline__ unsigned cvtpk(float lo, float hi) { unsigned r; asm volatile("v_cvt_pk_bf16_f32 %0, %1, %2" : "=v"(r) : "v"(lo), "v"(hi)); return r; }
__device__ __forceinline__ void partialSM(f32x16& p0, f32x16& p1, float& m_reg, float& mn, float& alpha) {
  constexpr float C = SCALE * 1.4426950408889634f;
  float pmax = p0[0];
#pragma unroll
  for (int r = 1; r < 16; ++r) pmax = fmaxf(pmax, p0[r]);
#pragma unroll
  for (int r = 0; r < 16; ++r) pmax = fmaxf(pmax, p1[r]);
  { auto rr = __builtin_amdgcn_permlane32_swap(__float_as_uint(pmax), __float_as_uint(pmax), false, false);
    pmax = fmaxf(__uint_as_float(rr[0]), __uint_as_float(rr[1])); }
  if (__builtin_expect(__all(pmax - m_reg <= THR / SCALE), 1)) { mn = m_reg; alpha = 1.f; }
  else { mn = fmaxf(m_reg, pmax); alpha = __builtin_amdgcn_exp2f((m_reg - mn) * C); m_reg = mn; }
  float mnC = -mn * C;
#pragma unroll
  for (int r = 0; r < 16; ++r) p0[r] = fmaf(p0[r], C, mnC);
#pragma unroll
  for (int r = 0; r < 16; ++r) p1[r] = fmaf(p1[r], C, mnC);
#pragma unroll
  for (int r = 0; r < 16; ++r) p0[r] = __builtin_amdgcn_exp2f(p0[r]);
}
__device__ __forceinline__ void finishSM(f32x16& p0, f32x16& p1, float alpha, float& l_reg, bf16x8& pa0, bf16x8& pa1, bf16x8& pa2, bf16x8& pa3) {
#pragma unroll
  for (int r = 0; r < 16; ++r) p1[r] = __builtin_amdgcn_exp2f(p1[r]);
  float ps = 0;
#pragma unroll
  for (int r = 0; r < 16; ++r) ps += p0[r];
#pragma unroll
  for (int r = 0; r < 16; ++r) ps += p1[r];
  { auto rr = __builtin_amdgcn_permlane32_swap(__float_as_uint(ps), __float_as_uint(ps), false, false);
    ps = __uint_as_float(rr[0]) + __uint_as_float(rr[1]); }
  l_reg = l_reg * alpha + ps;
#define PK4(P, BASE, OUT) do { unsigned a0 = cvtpk(P[BASE + 0], P[BASE + 1]), a1 = cvtpk(P[BASE + 2], P[BASE + 3]);   \
    unsigned b0 = cvtpk(P[BASE + 4], P[BASE + 5]), b1 = cvtpk(P[BASE + 6], P[BASE + 7]);                              \
    auto r0 = __builtin_amdgcn_permlane32_swap(a0, b0, false, false); auto r1 = __builtin_amdgcn_permlane32_swap(a1, b1, false, false); \
    u32x4 w = {r0[0], r1[0], r0[1], r1[1]}; OUT = *reinterpret_cast<bf16x8*>(&w); } while (0)
  PK4(p0, 0, pa0); PK4(p0, 8, pa1); PK4(p1, 0, pa2); PK4(p1, 8, pa3);
#undef PK4
}
__device__ __forceinline__ void qkt(f32x16& p0, f32x16& p1, const bf16* Ks, const bf16x8* qr, int r32, int hi) {
  p0 = f32x16{}; p1 = f32x16{};
#pragma unroll
  for (int d0 = 0; d0 < 8; ++d0) { int cb = (d0 * 16 + hi * 8) * 2;
    bf16x8 b0 = *reinterpret_cast<const bf16x8*>((const char*)Ks + KSWZ(r32, cb));
    bf16x8 b1 = *reinterpret_cast<const bf16x8*>((const char*)Ks + KSWZ(32 + r32, cb));
    p0 = MFMA32(b0, qr[d0], p0);
    p1 = MFMA32(b1, qr[d0], p1); }
}
__device__ __forceinline__ int v_st(int k, int c) { const int kk = (k & ~0xC) | ((k & 4) << 1) | ((k & 8) >> 1); return ((kk >> 3) * 4 + (c >> 5)) * 512 + ((kk & 7) * 32 + (c & 31)) * 2; }
__device__ __forceinline__ int v_rd_base(int lane) { return ((lane & 3) << 3) | (((lane >> 2) & 3) << 6) | (((lane >> 4) & 1) << 5) | (((lane >> 5) & 1) << 8); }
constexpr int v_rd_off(int d0, int ks, int half) { return d0 * 512 + ks * 4096 + half * 2048; }
template <int OFF> __device__ __forceinline__ s16x4 tr_read(int vb) {
  s16x4 r; asm volatile("ds_read_b64_tr_b16 %0, %1 offset:%2" : "=&v"(r) : "v"(vb), "i"(OFF) : "memory"); return r;
}
template <int D0> __device__ __forceinline__ void pv_one(f32x16& od, int vb, bf16x8 pa0, bf16x8 pa1, bf16x8 pa2, bf16x8 pa3) {
  const s16x4 l0 = tr_read<v_rd_off(D0, 0, 0)>(vb), h0 = tr_read<v_rd_off(D0, 0, 1)>(vb), l1 = tr_read<v_rd_off(D0, 1, 0)>(vb), h1 = tr_read<v_rd_off(D0, 1, 1)>(vb);
  const s16x4 l2 = tr_read<v_rd_off(D0, 2, 0)>(vb), h2 = tr_read<v_rd_off(D0, 2, 1)>(vb), l3 = tr_read<v_rd_off(D0, 3, 0)>(vb), h3 = tr_read<v_rd_off(D0, 3, 1)>(vb);
  asm volatile("s_waitcnt lgkmcnt(0)" ::: "memory"); SBAR();
#define PK(L, H) (bf16x8){L[0], L[1], L[2], L[3], H[0], H[1], H[2], H[3]}
  od = MFMA32(pa0, PK(l0, h0), od);
  od = MFMA32(pa1, PK(l1, h1), od);
  od = MFMA32(pa2, PK(l2, h2), od);
  od = MFMA32(pa3, PK(l3, h3), od);
#undef PK
}
__device__ __forceinline__ void pv_d0(f32x16* o, int vb, bf16x8 pa0, bf16x8 pa1, bf16x8 pa2, bf16x8 pa3) {
  pv_one<0>(o[0], vb, pa0, pa1, pa2, pa3); pv_one<1>(o[1], vb, pa0, pa1, pa2, pa3); pv_one<2>(o[2], vb, pa0, pa1, pa2, pa3); pv_one<3>(o[3], vb, pa0, pa1, pa2, pa3);
}
__device__ __forceinline__ void attn_dense_body(const bf16* __restrict__ Qb, const bf16* __restrict__ Kh, const bf16* __restrict__ Vh, bf16* __restrict__ Ob, int seq, char* lds) {
  int tid_ = threadIdx.x; asm volatile("" : "+v"(tid_));
  const int tid = tid_, wid = tid >> 6, lane = tid & 63, r32 = lane & 31, hi = lane >> 5;
  bf16* V_lds = (bf16*)lds; bf16* K_lds = (bf16*)(lds + 2 * SHM_V);
  float* ws = (float*)(lds + 2 * SHM_V + 2 * SHM_K) + wid * 64; float* li_l = ws; float* al_l = ws + 32;
  float m_reg = -1e30f, l_reg = 0; f32x16 o[4] = {}; bf16x8 qr[8];
  const bf16* Qw = Qb + (long)(wid * QBLK + r32) * LDQ + hi * 8;
#pragma unroll
  for (int d0 = 0; d0 < 8; ++d0) qr[d0] = *reinterpret_cast<const bf16x8*>(Qw + d0 * 16);
  const int sr = tid >> 4, sc = (tid & 15) * 8, vst0 = v_st(sr, sc), vst1 = v_st(32 + sr, sc);
  const int vb0 = (int)(uintptr_t)V_lds + v_rd_base(lane);
  struct { bf16x8 vs0, vs1, ks0, ks1; } sr_[2];
  const unsigned go0 = (unsigned)(sr * LDK + sc), go1 = (unsigned)((32 + sr) * LDK + sc);
#define SLOAD(i, k0) do { const bf16* vb_ = Vh + (long)(k0) * LDK; const bf16* kb_ = Kh + (long)(k0) * LDK; \
    sr_[i].vs0 = *reinterpret_cast<const bf16x8*>(vb_ + go0); sr_[i].vs1 = *reinterpret_cast<const bf16x8*>(vb_ + go1); \
    sr_[i].ks0 = *reinterpret_cast<const bf16x8*>(kb_ + go0); sr_[i].ks1 = *reinterpret_cast<const bf16x8*>(kb_ + go1); } while (0)
#define SWRITE(b, i) do { *(bf16x8*)((char*)V_lds + (b) * SHM_V + vst0) = sr_[i].vs0;          \
    *(bf16x8*)((char*)V_lds + (b) * SHM_V + vst1) = sr_[i].vs1; int kc = sc * 2;               \
    *(bf16x8*)((char*)K_lds + (b) * SHM_K + KSWZ(sr, kc)) = sr_[i].ks0;                       \
    *(bf16x8*)((char*)K_lds + (b) * SHM_K + KSWZ(32 + sr, kc)) = sr_[i].ks1; } while (0)
#define SWAIT() asm volatile("s_waitcnt vmcnt(4)" ::: "memory")
#define RESC(a) do { if (__any((a) < 1.f)) { if (hi == 0) al_l[r32] = (a); asm volatile("s_waitcnt lgkmcnt(0)" ::: "memory"); \
    _Pragma("unroll") for (int d = 0; d < 4; ++d) _Pragma("unroll") for (int r = 0; r < 16; ++r) o[d][r] *= al_l[crow(r, hi)]; } } while (0)
  f32x16 pA0, pA1, pB0, pB1; float mnA, mnB, alA, alB; bf16x8 pa0, pa1, pa2, pa3; const int NT = seq / KVBLK;
  constexpr int SE = 0, SO = 1;
  SLOAD(SE, 0); asm volatile("s_waitcnt vmcnt(0)" ::: "memory"); SWRITE(0, SE); __syncthreads();
  qkt(pA0, pA1, K_lds, qr, r32, hi); partialSM(pA0, pA1, m_reg, mnA, alA);
  SLOAD(SO, KVBLK); if (2 < NT) SLOAD(SE, 2 * KVBLK);
  SWAIT(); SWRITE(1, SO); __syncthreads();
  for (int j = 1; j + 1 < NT; j += 2) {
    SBAR(); qkt(pB0, pB1, (bf16*)((char*)K_lds + SHM_K), qr, r32, hi);
    finishSM(pA0, pA1, alA, l_reg, pa0, pa1, pa2, pa3); SBAR();
    SLOAD(SO, (j + 2) * KVBLK); SBAR();
    pv_d0(o, vb0, pa0, pa1, pa2, pa3); partialSM(pB0, pB1, m_reg, mnB, alB);
    __syncthreads(); SWAIT(); SWRITE(0, SE);
    RESC(alB); __syncthreads();
    SBAR(); qkt(pA0, pA1, K_lds, qr, r32, hi);
    finishSM(pB0, pB1, alB, l_reg, pa0, pa1, pa2, pa3); SBAR();
    if (j + 3 < NT) SLOAD(SE, (j + 3) * KVBLK); SBAR();
    pv_d0(o, vb0 + (int)SHM_V, pa0, pa1, pa2, pa3); partialSM(pA0, pA1, m_reg, mnA, alA);
    __syncthreads(); SWAIT(); SWRITE(1, SO);
    RESC(alA); __syncthreads();
  }
  SBAR(); qkt(pB0, pB1, (bf16*)((char*)K_lds + SHM_K), qr, r32, hi);
  finishSM(pA0, pA1, alA, l_reg, pa0, pa1, pa2, pa3); SBAR();
  pv_d0(o, vb0, pa0, pa1, pa2, pa3); partialSM(pB0, pB1, m_reg, mnB, alB);
  __syncthreads(); RESC(alB);
  finishSM(pB0, pB1, alB, l_reg, pa0, pa1, pa2, pa3); SBAR();
  pv_d0(o, vb0 + (int)SHM_V, pa0, pa1, pa2, pa3);
  if (hi == 0) li_l[r32] = l_reg; asm volatile("s_waitcnt lgkmcnt(0)" ::: "memory");
  float rli[16];
#pragma unroll
  for (int r = 0; r < 16; ++r) rli[r] = __builtin_amdgcn_rcpf(li_l[crow(r, hi)]);
  bf16* Ow = Ob + (long)(wid * QBLK) * LDO; const unsigned oo = (unsigned)(4 * hi * LDO + r32);
#pragma unroll
  for (int r = 0; r < 16; ++r) { const unsigned off = oo + (unsigned)(((r & 3) + 8 * (r >> 2)) * LDO);
#pragma unroll
    for (int d0 = 0; d0 < 4; ++d0) Ow[off + d0 * 32] = f2bf(o[d0][r] * rli[r]); }
#undef SLOAD
#undef SWRITE
#undef SWAIT
#undef RESC
}
}

namespace mk {
#define LDS_WAIT() asm volatile("s_waitcnt lgkmcnt(0)" ::: "memory")

__device__ __forceinline__ void transpose_item(const float* W, size_t ldw, bf16* WT, size_t Kd, int k0, int nsrc0, int ndst0, LAS float* scr, int lane) {
#pragma unroll 8
    for (int i = 0; i < 32; ++i) { const int kk = 2 * i + (lane >> 5); scr[kk * 33 + (lane & 31)] = W[(size_t)(k0 + kk) * ldw + nsrc0 + (lane & 31)]; }
    LDS_WAIT(); asm volatile("" ::: "memory");
    const int c = lane & 7;
#pragma unroll
    for (int j = 0; j < 4; ++j) { const int n = (lane >> 3) + 8 * j; const LAS float* s = scr + (8 * c) * 33 + n;
        u32x4 o; o.x = pk2(s[0 * 33], s[1 * 33]); o.y = pk2(s[2 * 33], s[3 * 33]); o.z = pk2(s[4 * 33], s[5 * 33]); o.w = pk2(s[6 * 33], s[7 * 33]);
        *(u32x4*)(WT + (size_t)(ndst0 + n) * Kd + k0 + 8 * c) = o; }
    LDS_WAIT(); asm volatile("" ::: "memory");
}
constexpr int IT_WIN = 32 * 609, IT_WBR = 3 * 32 * 64, IT_WOUT = 32 * 64, IT_WF1 = 32 * 352, IT_WF2 = 88 * 64, IT_LRU = 512;
constexpr int IT_LAYER = IT_WIN + IT_WBR + IT_WOUT + IT_WF1 + IT_WF2 + IT_LRU;

__device__ __forceinline__ void phase_prologue(Frame& F) {
    refresh(F);
    const int gw = F.vcu * NWAVES + F.wave, NGW = F.G * NWAVES, lane = F.lane;
    LAS float* scr = (LAS float*)(F.lds + F.wave * 16384);
    unsigned char* ws = F.ws;
    for (int it = gw; it < DEPTH * IT_LAYER; it += NGW) {
        const int l = it / IT_LAYER; int r = it - l * IT_LAYER;
        if (r < IT_WIN) { const int kb = r / 609, nb = r - kb * 609, ns = 32 * nb; const int nd = ns < 6144 ? ns : (ns < 6176 ? 19456 + (ns - 6144) : ns - 32);
            transpose_item(F.ka->in[I_WIN] + (size_t)l * D * NIN, NIN, (bf16*)(ws + WS_WIN + l * WIN_L), KP, 64 * kb, ns, nd, scr, lane); continue; }
        r -= IT_WIN;
        if (r < IT_WBR) { const int n = r / 2048, rr = r - n * 2048, kb = rr >> 6, nb = rr & 63;
            transpose_item(F.ka->in[I_WBR] + ((size_t)l * 3 + n) * D * D, D, (bf16*)(ws + WS_WBR + l * WBR_L), KP, 64 * kb, 32 * nb, n * 2048 + 32 * nb, scr, lane); continue; }
        r -= IT_WBR;
        if (r < IT_WOUT) { const int kb = r >> 6, nb = r & 63;
            transpose_item(F.ka->in[I_WOUT] + (size_t)l * D * D, D, (bf16*)(ws + WS_WOUT + l * WOUT_L), KP, 64 * kb, 32 * nb, 32 * nb, scr, lane); continue; }
        r -= IT_WOUT;
        if (r < IT_WF1) { const int kb = r / 352, nb = r - kb * 352, ns = 32 * nb; const int up = ns >= FF ? 1 : 0, j = ns - up * FF; const int nd = (j >> 7) * 256 + up * 128 + (j & 127);
            transpose_item(F.ka->in[I_WF1] + (size_t)l * D * NF1, NF1, (bf16*)(ws + WS_WF1 + l * WF1_L), KP, 64 * kb, ns, nd, scr, lane); continue; }
        r -= IT_WF1;
        if (r < IT_WF2) { const int kb = r >> 6, nb = r & 63;
            transpose_item(F.ka->in[I_WF2] + (size_t)l * FF * D, D, (bf16*)(ws + WS_WF2 + l * WF2_L), FF, 64 * kb, 32 * nb, 32 * nb, scr, lane); continue; }
        r -= IT_WF2;
        {
            const int sub = r & 7, mat = r >> 3, gate = mat & 1, n = (mat >> 1) & 15, dir = mat >> 5, kb = sub >> 2, nb = sub & 3;
            const float* W = (gate ? F.ka->in[I_LWI] : F.ka->in[I_LWA]) + (((size_t)l * 2 + dir) * 16 + n) * 128 * 128;
            transpose_item(W, 128, ((bf16*)(F.ws + WS_WL)) + ((size_t)l * 16 + n) * 512 * 128, 128, 64 * kb, 32 * nb, (dir * 2 + gate) * 128 + 32 * nb, scr, lane); }
    }
    for (int i = gw * 64 + lane; i < DEPTH * 224 * 256; i += NGW * 64) { const int l = i / (224 * 256), r = i - l * 224 * 256;
        *(u32x4*)((bf16*)(ws + WS_WIN + l * WIN_L) + (size_t)(NIN + (r >> 8)) * KP + (size_t)(r & 255) * 8) = (u32x4){0u, 0u, 0u, 0u}; }
    for (int row = gw; row < M; row += NGW) { const int b = row / TT, t = row - b * TT;
        const f32x4* src = (const f32x4*)(t < TL ? F.ka->in[I_X] + ((size_t)b * TL + t) * D : F.ka->in[I_CTX] + ((size_t)b * LC + (t - TL)) * D);
        f32x4* dst = (f32x4*)(((float*)(F.ws + WS_H)) + (size_t)row * D);
#pragma unroll
        for (int j = 0; j < 8; ++j) dst[lane + 64 * j] = src[lane + 64 * j]; }
    for (int i = gw * 64 + lane; i < TL * 64; i += NGW * 64) { const int t = i >> 6, p = i & 63; const int rr = t >> 6, cc = t & 63;
        const float inv = exp2f(-(float)(p & 31) * (13.287712379549449f / 32.0f)); const float ang = (float)(p < 32 ? rr : cc) * inv;
        ((float*)(F.ws + WS_ROPE))[i] = cosf(ang); ((float*)(F.ws + WS_ROPE))[TL * 64 + i] = sinf(ang); }
    __syncthreads();
    LAS float* SC = (LAS float*)F.lds; LAS float* RED = (LAS float*)(F.lds + 40960);
    for (int i = F.tid; i < 5 * D; i += NTHR) { const int rt = i / D, k = i - rt * D; const float c = rt < 4 ? F.ka->in[I_C][rt * D + k] : F.ka->in[I_CCTX][k]; SC[i] = siluf_(c); }
    __syncthreads();
    for (int u = F.vcu; u < DEPTH * 192; u += F.G) { const int l = u / 192, cb = u - l * 192; const int cg = F.tid & 15, ks = F.tid >> 4;
        const float* wp = F.ka->in[I_WMOD] + ((size_t)l * D + ks * 64) * (6 * D) + cb * 64 + cg * 4;
        f32x4 a0 = {0, 0, 0, 0}, a1 = a0, a2 = a0, a3 = a0, a4 = a0;
#pragma unroll 8
        for (int k = 0; k < 64; ++k) { const f32x4 w = *(const f32x4*)(wp + (size_t)k * (6 * D)); const int kk = ks * 64 + k;
            a0 += SC[kk] * w; a1 += SC[D + kk] * w; a2 += SC[2 * D + kk] * w; a3 += SC[3 * D + kk] * w; a4 += SC[4 * D + kk] * w; }
        *(LAS f32x4*)(RED + (ks * 5 + 0) * 64 + cg * 4) = a0; *(LAS f32x4*)(RED + (ks * 5 + 1) * 64 + cg * 4) = a1; *(LAS f32x4*)(RED + (ks * 5 + 2) * 64 + cg * 4) = a2;
        *(LAS f32x4*)(RED + (ks * 5 + 3) * 64 + cg * 4) = a3; *(LAS f32x4*)(RED + (ks * 5 + 4) * 64 + cg * 4) = a4;
        __syncthreads();
        if (F.tid < 320) { const int rt = F.tid >> 6, c = F.tid & 63; float s = F.ka->in[I_BMOD][(size_t)l * 6 * D + cb * 64 + c];
#pragma unroll 8
            for (int k2 = 0; k2 < 32; ++k2) s += RED[(k2 * 5 + rt) * 64 + c];
            ((float*)(F.ws + WS_MOD))[((size_t)l * 5 + rt) * (6 * D) + cb * 64 + c] = s; }
        __syncthreads();
    }
}

__device__ __forceinline__ void phase_norm(Frame& F, int l, const float* gain, int i_shift, int i_scale, int ymode, int lat_only) {
    refresh(F);
    const int gw = F.vcu * NWAVES + F.wave, NGW = F.G * NWAVES, lane = F.lane;
    for (int row = gw; row < M; row += NGW) { const int b = row / TT, t = row - b * TT, rt = t < TL ? b : 4;
        if (lat_only && t >= TL) continue;
        f32x4* hp = (f32x4*)(((float*)(F.ws + WS_H)) + (size_t)row * D); f32x4 v[8]; float ss = 0.f;
#pragma unroll
        for (int j = 0; j < 8; ++j) v[j] = hp[lane + 64 * j];
        if (ymode != 0) {
            if (t < TL) { const u32x2* yp = (const u32x2*)(((bf16*)(F.ws + WS_Y)) + (size_t)row * D);
#pragma unroll
                for (int j = 0; j < 8; ++j) { const u32x2 y = yp[lane + 64 * j]; v[j].x += bflo(y.x); v[j].y += bfhi(y.x); v[j].z += bflo(y.y); v[j].w += bfhi(y.y); } }
            else { const f32x4* sp = (const f32x4*)(((float*)(F.ws + WS_SLAB)) + ((size_t)b * 256 + (t - TL)) * D);
#pragma unroll
                for (int p = 0; p < 8; ++p)
#pragma unroll
                    for (int j = 0; j < 8; ++j) v[j] += sp[(size_t)p * (1024 * D / 4) + lane + 64 * j]; }
#pragma unroll
            for (int j = 0; j < 8; ++j) hp[lane + 64 * j] = v[j]; }
#pragma unroll
        for (int j = 0; j < 8; ++j) ss += (v[j].x * v[j].x + v[j].y * v[j].y) + (v[j].z * v[j].z + v[j].w * v[j].w);
        const float rstd = 1.0f / sqrtf(wave_sum(ss) * (1.0f / D) + EPS);
        const float* mod = ((float*)(F.ws + WS_MOD)) + ((size_t)l * 5 + rt) * (6 * D);
        u32x2* up = (u32x2*)(((bf16*)(F.ws + WS_U)) + (size_t)row * KP);
#pragma unroll
        for (int j = 0; j < 8; ++j) { const int c4 = lane + 64 * j; const f32x4 g = ((const f32x4*)gain)[c4], sc = ((const f32x4*)(mod + i_scale * D))[c4], sh = ((const f32x4*)(mod + i_shift * D))[c4];
            const f32x4 o = (v[j] * rstd * g) * (sc + 1.0f) + sh; u32x2 w; w.x = pk2(o.x, o.y); w.y = pk2(o.z, o.w); up[c4] = w; } }
}
__device__ __forceinline__ void phase_final(Frame& F) {
    refresh(F);
    const int gw = F.vcu * NWAVES + F.wave, NGW = F.G * NWAVES, lane = F.lane; const float* gain = F.ka->in[I_FNG];
    for (int idx = gw; idx < NB * TL; idx += NGW) { const int b = idx / TL, t = idx - b * TL; const size_t row = (size_t)b * TT + t;
        const f32x4* hp = (const f32x4*)(((float*)(F.ws + WS_H)) + row * D); const u32x2* yp = (const u32x2*)(((bf16*)(F.ws + WS_Y)) + row * D); f32x4 v[8]; float ss = 0.f;
#pragma unroll
        for (int j = 0; j < 8; ++j) { v[j] = hp[lane + 64 * j]; const u32x2 y = yp[lane + 64 * j]; v[j].x += bflo(y.x); v[j].y += bfhi(y.x); v[j].z += bflo(y.y); v[j].w += bfhi(y.y);
            ss += (v[j].x * v[j].x + v[j].y * v[j].y) + (v[j].z * v[j].z + v[j].w * v[j].w); }
        const float rstd = 1.0f / sqrtf(wave_sum(ss) * (1.0f / D) + EPS);
        f32x4* op = (f32x4*)(F.ka->out + (size_t)idx * D);
#pragma unroll
        for (int j = 0; j < 8; ++j) { const int c4 = lane + 64 * j; op[c4] = v[j] * rstd * ((const f32x4*)gain)[c4]; } }
}

__device__ __forceinline__ void prep_attn(Frame& F, int l) {
    refresh(F);
    const int gw = F.vcu * NWAVES + F.wave, NGW = F.G * NWAVES, lane = F.lane;
    const float gq0 = F.ka->in[I_QNG][l * 128 + 2 * lane], gq1 = F.ka->in[I_QNG][l * 128 + 2 * lane + 1], gk0 = F.ka->in[I_KNG][l * 128 + 2 * lane], gk1 = F.ka->in[I_KNG][l * 128 + 2 * lane + 1];
    for (int row = gw; row < M; row += NGW) { const int t = row % TT; const bool lat = t < TL;
        unsigned* base = (unsigned*)(((bf16*)(F.ws + WS_PROJ)) + (size_t)row * NP + C_AQ) + lane;
        float cs = 1.f, sn = 0.f; if (lat) { cs = ((float*)(F.ws + WS_ROPE))[t * 64 + lane]; sn = ((float*)(F.ws + WS_ROPE))[TL * 64 + t * 64 + lane]; }
        unsigned x[20];
#pragma unroll
        for (int h = 0; h < 20; ++h) x[h] = base[h * 64];
#pragma unroll
        for (int h = 0; h < 20; ++h) { const float x1 = bflo(x[h]), x2 = bfhi(x[h]); const float ss = wave_sum(x1 * x1 + x2 * x2);
            const float rstd = 1.0f / sqrtf(ss * (1.0f / 128.0f) + EPS); const float y1 = x1 * rstd * (h < 16 ? gq0 : gk0), y2 = x2 * rstd * (h < 16 ? gq1 : gk1);
            base[h * 64] = pk2(y1 * cs - y2 * sn, y1 * sn + y2 * cs); } }
}
__device__ __forceinline__ void prep_gla(Frame& F, int l) {
    refresh(F);
    LAS float* DECs = (LAS float*)F.lds;
    const int tid = F.tid, dir = F.wave >> 2, cp = tid & 255;
    for (int u = F.vcu; u < 288; u += F.G) { const int b = u / 72, rem = u - b * 72, c = rem >> 1, half = rem & 1; const size_t R0 = (size_t)b * TT + 64 * c;
        __syncthreads();
        *(LAS f32x4*)(DECs + tid * 4) = *(const f32x4*)(((float*)(F.ws + WS_DEC)) + R0 * 32 + tid * 4);
        __syncthreads();
        const int k0 = half * 512 + 2 * cp;
        f32x2 wv[16];
#pragma unroll
        for (int r = 0; r < 16; ++r) wv[r] = *(const f32x2*)(F.ka->in[I_GWD] + (((size_t)l * 2 + dir) * 16 + r) * 1024 + k0);
        const f32x2 bd = *(const f32x2*)(F.ka->in[I_GBD] + ((size_t)l * 2 + dir) * 1024 + k0);
        const bf16* pq = ((bf16*)(F.ws + WS_PROJ)) + R0 * NP + C_GQ; const bf16* pk = ((bf16*)(F.ws + WS_PROJ)) + R0 * NP + C_GK;
        bf16* QDp = ((bf16*)(F.ws + WS_QD)) + ((size_t)dir * M + R0) * 1024; bf16* KNp = ((bf16*)(F.ws + WS_QD)) + ((size_t)(2 + dir) * M + R0) * 1024;
        f32x2 run = {0.f, 0.f};
#pragma unroll 8
        for (int i = 0; i < 64; ++i) { const int t = dir ? 63 - i : i; f32x2 z = bd;
#pragma unroll
            for (int r4 = 0; r4 < 4; ++r4) { const f32x4 dv = *(const LAS f32x4*)(DECs + t * 32 + dir * 16 + 4 * r4);
                z += dv.x * wv[4 * r4] + dv.y * wv[4 * r4 + 1] + dv.z * wv[4 * r4 + 2] + dv.w * wv[4 * r4 + 3]; }
            run.x += (fminf(z.x, 0.f) - __logf(1.0f + __expf(-fabsf(z.x)))) * 0.0625f; run.y += (fminf(z.y, 0.f) - __logf(1.0f + __expf(-fabsf(z.y)))) * 0.0625f;
            const unsigned q2 = *(const unsigned*)(pq + (unsigned)(t * NP + k0)), k2 = *(const unsigned*)(pk + (unsigned)(t * NP + k0));
            const float e0 = __expf(run.x), e1 = __expf(run.y), n0 = __expf(-run.x), n1 = __expf(-run.y);
            *(unsigned*)(QDp + (unsigned)(t * 1024 + k0)) = pk2(bflo(q2) * 0.0625f * e0, bfhi(q2) * 0.0625f * e1);
            *(unsigned*)(KNp + (unsigned)(t * 1024 + k0)) = pk2(bflo(k2) * n0, bfhi(k2) * n1); }
        { f32x2 dl; dl.x = __expf(run.x); dl.y = __expf(run.y); *(f32x2*)(((float*)(F.ws + WS_DL)) + ((size_t)dir * 144 + b * 36 + c) * 1024 + k0) = dl; }
    }
}
__device__ __forceinline__ void prep_lru(Frame& F, int l) {
    refresh(F);
    constexpr int XBS = 272, XFS = 528, O_XF = 64 * XBS;
    LAS unsigned char* lds = F.lds;
    const int tid = F.tid, lane = F.lane, wv = F.wave, i16 = lane & 15, g4 = lane >> 4;
    const int n = F.vcu & 15, slot = F.vcu >> 4, nslot = F.G >> 4;
    bf16x8 Bf[4][4];
#pragma unroll
    for (int gi = 0; gi < 4; ++gi)
#pragma unroll
        for (int ks = 0; ks < 4; ++ks) Bf[gi][ks] = *(const bf16x8*)(((bf16*)(F.ws + WS_WL)) + (((size_t)l * 16 + n) * 512 + gi * 128 + 16 * wv + i16) * 128 + 32 * ks + 8 * g4);
    const int C = 128 * n + 16 * wv + i16;
    float ba[2], bi[2], sp8[2];
#pragma unroll
    for (int d = 0; d < 2; ++d) { ba[d] = F.ka->in[I_LBA][((size_t)l * 2 + d) * D + C]; bi[d] = F.ka->in[I_LBI][((size_t)l * 2 + d) * D + C];
        const float lam = F.ka->in[I_LAM][((size_t)l * 2 + d) * D + C]; sp8[d] = 8.0f * (fmaxf(-lam, 0.f) + __logf(1.0f + __expf(-fabsf(lam)))); }
    const int cgp = tid & 15, tk = tid >> 4; const int cch = 128 * n + 8 * cgp;
    for (int tt = slot; tt < M / 64; tt += nslot) { const int R0 = 64 * tt, b = R0 / TT, tq = R0 - b * TT;
        const int seq_lo = tq < TL ? b * TT : b * TT + TL, seq_hi = tq < TL ? b * TT + TL : (b + 1) * TT;
        f32x4 cw[4][2], cbv[2];
#pragma unroll
        for (int j = 0; j < 4; ++j) { cw[j][0] = *(const f32x4*)(F.ka->in[I_CW] + ((size_t)l * 4 + j) * D + cch); cw[j][1] = *(const f32x4*)(F.ka->in[I_CW] + ((size_t)l * 4 + j) * D + cch + 4); }
        cbv[0] = *(const f32x4*)(F.ka->in[I_CB] + (size_t)l * D + cch); cbv[1] = *(const f32x4*)(F.ka->in[I_CB] + (size_t)l * D + cch + 4);
#pragma unroll
        for (int q = 0; q < 2; ++q) { const int tok = tk + 32 * q, row = R0 + tok; f32x4 a0 = cbv[0], a1 = cbv[1];
#pragma unroll
            for (int j = 0; j < 4; ++j) { const int rr = row + j - 2; u32x4 xv = {0u, 0u, 0u, 0u};
                if (rr >= seq_lo && rr < seq_hi) xv = *(const u32x4*)(((bf16*)(F.ws + WS_PROJ)) + (size_t)rr * NP + C_LX + cch);
                f32x4 x0 = {bflo(xv.x), bfhi(xv.x), bflo(xv.y), bfhi(xv.y)}, x1 = {bflo(xv.z), bfhi(xv.z), bflo(xv.w), bfhi(xv.w)};
                a0 += cw[j][0] * x0; a1 += cw[j][1] * x1; }
            *(LAS f32x4*)(lds + O_XF + tok * XFS + cgp * 32) = a0; *(LAS f32x4*)(lds + O_XF + tok * XFS + cgp * 32 + 16) = a1;
            u32x4 w; w.x = pk2(a0.x, a0.y); w.y = pk2(a0.z, a0.w); w.z = pk2(a1.x, a1.y); w.w = pk2(a1.z, a1.w);
            *(LAS u32x4*)(lds + tok * XBS + cgp * 16) = w; }
        __syncthreads();
        f32x4 acc[4][4];
#pragma unroll
        for (int tb = 0; tb < 4; ++tb)
#pragma unroll
            for (int gi = 0; gi < 4; ++gi) acc[tb][gi] = (f32x4){0.f, 0.f, 0.f, 0.f};
#pragma unroll
        for (int tb = 0; tb < 4; ++tb)
#pragma unroll
            for (int ks = 0; ks < 4; ++ks) { const bf16x8 a = *(const LAS bf16x8*)(lds + (16 * tb + i16) * XBS + (32 * ks + 8 * g4) * 2);
#pragma unroll
                for (int gi = 0; gi < 4; ++gi) acc[tb][gi] = MFMA16(a, Bf[gi][ks], acc[tb][gi]); }
        const int first0 = b * TT + TL, first1 = b * TT + TL + LC - 1;
#pragma unroll
        for (int tb = 0; tb < 4; ++tb)
#pragma unroll
            for (int rg = 0; rg < 4; ++rg) { const int tok = 16 * tb + 4 * g4 + rg, row = R0 + tok; const float x = *(const LAS float*)(lds + O_XF + tok * XFS + (16 * wv + i16) * 4);
#pragma unroll
                for (int d = 0; d < 2; ++d) { const float r = sigmoidf_(acc[tb][2 * d][rg] + ba[d]), ig = sigmoidf_(acc[tb][2 * d + 1][rg] + bi[d]);
                    const float la = -r * sp8[d], a = __expf(la); float mult = sqrtf(fmaxf(1.0f - a * a, 0.f)); if (row == (d ? first1 : first0)) mult = 1.0f;
                    ((bf16*)(F.ws + WS_LA))[((size_t)d * M + row) * D + C] = f2bf(la); ((bf16*)(F.ws + WS_LA))[((size_t)(2 + d) * M + row) * D + C] = f2bf(mult * ig * x); } }
        __syncthreads();
    }
}

__device__ __forceinline__ void gla_unit(Frame& F, int unit) {
    refresh(F);
    constexpr int QS = 528, KS = 576, AS = 144;
    constexpr int O_QD = 0, O_KN = 33792, O_KD = 67584, O_V = 104448, O_ATT = 141312, O_DL = 150528;
    LAS unsigned char* lds = F.lds;
    const int wv = F.wave;
    const int b = unit >> 4, hd = (unit >> 2) & 3, dir = (unit >> 1) & 1, half = unit & 1;
    const bf16* gQD = ((bf16*)(F.ws + WS_QD)) + (size_t)dir * M * 1024 + hd * 256; const bf16* gKN = ((bf16*)(F.ws + WS_QD)) + (size_t)(2 + dir) * M * 1024 + hd * 256;
    const bf16* gV = ((bf16*)(F.ws + WS_PROJ)) + C_GV + hd * 512 + half * 256;
    bf16* gO = (dir ? ((bf16*)(F.ws + WS_OB)) : ((bf16*)(F.ws + WS_OF))) + hd * 512 + half * 256 + 32 * wv;
    const float* gDL = ((float*)(F.ws + WS_DL)) + ((size_t)dir * 144 + b * 36) * 1024 + hd * 256;
    f32x16 S[8];
#pragma unroll
    for (int i = 0; i < 8; ++i) S[i] = f32x16{};
    u32x4 pq[4], pn[4], pv[4]; f32x4 pdl;
#define GLA_CHUNK(s_) (dir ? 35 - (s_) : ((s_) < 4 ? 32 + (s_) : (s_) - 4))
#define GLA_PREFETCH(s_) do { const int c_ = GLA_CHUNK(s_); const size_t R_ = (size_t)b * TT + 64 * c_; \
        _Pragma("unroll") for (int i = 0; i < 4; ++i) { pq[i] = *(const u32x4*)(gQD + (R_ + 16 * i) * 1024 + vq); pn[i] = *(const u32x4*)(gKN + (R_ + 16 * i) * 1024 + vq); } } while (0)
    { const int tid = F.tid; const unsigned vq = (unsigned)((tid >> 5) * 1024 + 8 * (tid & 31)); GLA_PREFETCH(0); }
    for (int s = 0; s < 36; ++s) {
        int t_ = F.tid; asm volatile("" : "+v"(t_));
        const int tid = t_, lane = tid & 63, r32 = lane & 31, hh = lane >> 5, i16 = lane & 15, g4 = lane >> 4;
        const unsigned vq = (unsigned)((tid >> 5) * 1024 + 8 * (tid & 31)), vv = (unsigned)((tid >> 5) * NP + 8 * (tid & 31));
        LAS unsigned char* lq = lds + (tid >> 5) * QS + 16 * (tid & 31); LAS unsigned char* lk = lds + (tid >> 5) * KS + 16 * (tid & 31);
        const int c = GLA_CHUNK(s); const size_t R0 = (size_t)b * TT + 64 * c;
#pragma unroll
        for (int i = 0; i < 4; ++i) { *(LAS u32x4*)(lq + O_QD + i * 16 * QS) = pq[i]; *(LAS u32x4*)(lq + O_KN + i * 16 * QS) = pn[i]; *(LAS u32x4*)(lk + O_KD + i * 16 * KS) = pn[i]; }
#pragma unroll
        for (int i = 0; i < 4; ++i) pv[i] = *(const u32x4*)(gV + (R0 + 16 * i) * NP + vv);
        pdl = *(const f32x4*)(gDL + (size_t)c * 1024 + (tid & 63) * 4);
        __syncthreads();
        { const int ib = wv >> 1, jb0 = 2 * (wv & 1); f32x4 at0 = {0.f, 0.f, 0.f, 0.f}, at1 = at0;
#pragma unroll
            for (int ks = 0; ks < 8; ++ks) { const int cb = (32 * ks + 8 * g4) * 2;
                const bf16x8 a = *(const LAS bf16x8*)(lds + O_QD + (16 * ib + i16) * QS + cb);
                const bf16x8 b0 = *(const LAS bf16x8*)(lds + O_KN + (16 * jb0 + i16) * QS + cb), b1 = *(const LAS bf16x8*)(lds + O_KN + (16 * (jb0 + 1) + i16) * QS + cb);
                at0 = MFMA16(a, b0, at0); at1 = MFMA16(a, b1, at1); }
#pragma unroll
            for (int rg = 0; rg < 4; ++rg) { const int i = 16 * ib + 4 * g4 + rg, j0 = 16 * jb0 + i16, j1 = j0 + 16;
                const bool k0 = dir ? (j0 >= i) : (j0 <= i), k1 = dir ? (j1 >= i) : (j1 <= i);
                *(LAS bf16*)(lds + O_ATT + i * AS + j0 * 2) = k0 ? f2bf(at0[rg]) : (bf16)0; *(LAS bf16*)(lds + O_ATT + i * AS + j1 * 2) = k1 ? f2bf(at1[rg]) : (bf16)0; } }
        f32x16 o0 = f32x16{}, o1 = f32x16{};
#pragma unroll
        for (int dkb = 0; dkb < 8; ++dkb)
#pragma unroll
            for (int st = 0; st < 2; ++st) { u32x4 pb; pb.x = pk2(S[dkb][8 * st + 0], S[dkb][8 * st + 1]); pb.y = pk2(S[dkb][8 * st + 2], S[dkb][8 * st + 3]);
                pb.z = pk2(S[dkb][8 * st + 4], S[dkb][8 * st + 5]); pb.w = pk2(S[dkb][8 * st + 6], S[dkb][8 * st + 7]); const bf16x8 bfr = __builtin_bit_cast(bf16x8, pb);
                const int dko = (32 * dkb + 16 * st + 4 * hh) * 2;
                const s16x4 l0 = *(const LAS s16x4*)(lds + O_QD + r32 * QS + dko), h0 = *(const LAS s16x4*)(lds + O_QD + r32 * QS + dko + 16);
                const s16x4 l1 = *(const LAS s16x4*)(lds + O_QD + (32 + r32) * QS + dko), h1 = *(const LAS s16x4*)(lds + O_QD + (32 + r32) * QS + dko + 16);
                o0 = MFMA32(cat8(l0, h0), bfr, o0); o1 = MFMA32(cat8(l1, h1), bfr, o1); }
#pragma unroll
        for (int i = 0; i < 4; ++i) *(LAS u32x4*)(lk + O_V + i * 16 * KS) = pv[i];
        if (tid < 64) *(LAS f32x4*)(lds + O_DL + tid * 16) = pdl;
        __syncthreads();
        bf16x8 Vf[4];
#pragma unroll
        for (int ks = 0; ks < 4; ++ks) { LAS unsigned char* p = lds + O_V + (16 * ks + 8 * hh + (i16 >> 2)) * KS + (32 * wv + 16 * (g4 & 1) + 4 * (i16 & 3)) * 2;
            Vf[ks] = cat8(vtr(p), vtr(p + 4 * KS)); }
#pragma unroll
        for (int ks = 0; ks < 4; ++ks) { const int cb = (16 * ks + 8 * hh) * 2;
            const bf16x8 a0 = *(const LAS bf16x8*)(lds + O_ATT + r32 * AS + cb), a1 = *(const LAS bf16x8*)(lds + O_ATT + (32 + r32) * AS + cb);
            o0 = MFMA32(a0, Vf[ks], o0); o1 = MFMA32(a1, Vf[ks], o1); }
        { bf16* ob = gO + R0 * D; const unsigned lo_ = (unsigned)(4 * hh * D + r32);
#pragma unroll
          for (int rg = 0; rg < 16; ++rg) { const unsigned off = lo_ + (unsigned)(((rg & 3) + 8 * (rg >> 2)) * D);
            ob[off] = f2bf(o0[rg]); ob[off + 32 * D] = f2bf(o1[rg]); } }
        if (s + 1 < 36) GLA_PREFETCH(s + 1);
#pragma unroll
        for (int dkb = 0; dkb < 8; ++dkb) {
#pragma unroll
            for (int ks = 0; ks < 4; ++ks) { LAS unsigned char* p = lds + O_KD + (16 * ks + 8 * hh + (i16 >> 2)) * KS + (32 * dkb + 16 * (g4 & 1) + 4 * (i16 & 3)) * 2;
                S[dkb] = MFMA32(cat8(vtr(p), vtr(p + 4 * KS)), Vf[ks], S[dkb]); }
#pragma unroll
            for (int q = 0; q < 4; ++q) { const f32x4 dl = *(const LAS f32x4*)(lds + O_DL + (32 * dkb + 8 * q + 4 * hh) * 4);
                S[dkb][4 * q + 0] *= dl.x; S[dkb][4 * q + 1] *= dl.y; S[dkb][4 * q + 2] *= dl.z; S[dkb][4 * q + 3] *= dl.w; } }
        __syncthreads();
    }
#undef GLA_CHUNK
#undef GLA_PREFETCH
}
__device__ __forceinline__ void lru_scan_unit(Frame& F, int unit) {
    refresh(F);
    LAS float* SEG = (LAS float*)F.lds;
    const int b = unit >> 5, d = (unit >> 4) & 1, g = unit & 15, cg = F.lane & 15, seg = F.wave * 4 + (F.lane >> 4), ch = 128 * g + 8 * cg;
    const bf16* la = ((bf16*)(F.ws + WS_LA)) + (size_t)d * M * D + ch; const bf16* bx = ((bf16*)(F.ws + WS_LA)) + (size_t)(2 + d) * M * D + ch; bf16* hs = ((bf16*)(F.ws + WS_HS)) + (size_t)d * M * D + ch;
    const int p0 = 72 * seg;
#define LRU_ROW(p) ((size_t)b * TT + (d == 0 ? ((p) < LC ? TL + (p) : (p) - LC) : ((p) < LC ? TL + LC - 1 - (p) : TL - 1 - ((p) - LC))))
    float h[8], A[8];
#pragma unroll
    for (int e = 0; e < 8; ++e) { h[e] = 0.f; A[e] = 1.f; }
#pragma unroll 8
    for (int i = 0; i < 72; ++i) { const size_t row = LRU_ROW(p0 + i); const u32x4 lv = *(const u32x4*)(la + row * D), bv = *(const u32x4*)(bx + row * D);
        const unsigned lw[4] = {lv.x, lv.y, lv.z, lv.w}, bw[4] = {bv.x, bv.y, bv.z, bv.w};
#pragma unroll
        for (int e = 0; e < 4; ++e) { const float a0 = __expf(bflo(lw[e])), a1 = __expf(bfhi(lw[e]));
            h[2 * e] = a0 * h[2 * e] + bflo(bw[e]); h[2 * e + 1] = a1 * h[2 * e + 1] + bfhi(bw[e]); A[2 * e] *= a0; A[2 * e + 1] *= a1; } }
    __syncthreads();
    { LAS float* sp = SEG + (seg * 16 + cg) * 16;
      *(LAS f32x4*)(sp) = (f32x4){A[0], A[1], A[2], A[3]}; *(LAS f32x4*)(sp + 4) = (f32x4){A[4], A[5], A[6], A[7]};
      *(LAS f32x4*)(sp + 8) = (f32x4){h[0], h[1], h[2], h[3]}; *(LAS f32x4*)(sp + 12) = (f32x4){h[4], h[5], h[6], h[7]}; }
    __syncthreads();
#pragma unroll
    for (int e = 0; e < 8; ++e) h[e] = 0.f;
    for (int s2 = 0; s2 < seg; ++s2) { const LAS float* sp = SEG + (s2 * 16 + cg) * 16;
        const f32x4 a0 = *(const LAS f32x4*)(sp), a1 = *(const LAS f32x4*)(sp + 4), h0 = *(const LAS f32x4*)(sp + 8), h1 = *(const LAS f32x4*)(sp + 12);
        h[0] = a0.x * h[0] + h0.x; h[1] = a0.y * h[1] + h0.y; h[2] = a0.z * h[2] + h0.z; h[3] = a0.w * h[3] + h0.w;
        h[4] = a1.x * h[4] + h1.x; h[5] = a1.y * h[5] + h1.y; h[6] = a1.z * h[6] + h1.z; h[7] = a1.w * h[7] + h1.w; }
#pragma unroll 8
    for (int i = 0; i < 72; ++i) { const size_t row = LRU_ROW(p0 + i); const u32x4 lv = *(const u32x4*)(la + row * D), bv = *(const u32x4*)(bx + row * D);
        const unsigned lw[4] = {lv.x, lv.y, lv.z, lv.w}, bw[4] = {bv.x, bv.y, bv.z, bv.w}; unsigned ow[4];
#pragma unroll
        for (int e = 0; e < 4; ++e) { const float a0 = __expf(bflo(lw[e])), a1 = __expf(bfhi(lw[e]));
            h[2 * e] = a0 * h[2 * e] + bflo(bw[e]); h[2 * e + 1] = a1 * h[2 * e + 1] + bfhi(bw[e]); ow[e] = pk2(h[2 * e], h[2 * e + 1]); }
        *(u32x4*)(hs + row * D) = (u32x4){ow[0], ow[1], ow[2], ow[3]}; }
#undef LRU_ROW
    __syncthreads();
}
__device__ __forceinline__ void attn_unit_latent(Frame& F, int idx) {
    const int qb = idx & 7, g = (idx >> 3) & 3, kvh = (idx >> 5) & 3, b = idx >> 7, h = kvh * 4 + g;
    const size_t r0 = (size_t)b * TT + 256 * qb, k0 = (size_t)b * TT;
    att::attn_dense_body(((bf16*)(F.ws + WS_PROJ)) + r0 * NP + C_AQ + h * 128, ((bf16*)(F.ws + WS_PROJ)) + k0 * NP + C_AK + kvh * 128, ((bf16*)(F.ws + WS_PROJ)) + k0 * NP + C_AV + kvh * 128, ((bf16*)(F.ws + WS_OBR)) + ((size_t)M + r0) * KP + h * 128, TT, (char*)F.lds);
    __syncthreads();
}
__device__ __forceinline__ void attn_unit_ctx(Frame& F, int idx) {
    const int h = idx & 15, b = idx >> 4, kvh = h >> 2; const size_t r0 = (size_t)b * TT + TL;
    att::attn_dense_body(((bf16*)(F.ws + WS_PROJ)) + r0 * NP + C_AQ + h * 128, ((bf16*)(F.ws + WS_PROJ)) + r0 * NP + C_AK + kvh * 128, ((bf16*)(F.ws + WS_PROJ)) + r0 * NP + C_AV + kvh * 128, ((bf16*)(F.ws + WS_OBR)) + ((size_t)M + r0) * KP + h * 128, LC, (char*)F.lds);
    __syncthreads();
}
__device__ __forceinline__ void phase_mix(Frame& F) {
    const int w = F.vcu;
    if (w < 64) { if constexpr (EN(6)) gla_unit(F, w); if constexpr (RP(7)) gla_unit(F, w); return; }
    const int w2 = w - 64, NA = F.G - 64;
    if constexpr (EN(7)) for (int idx = w2; idx < 512; idx += NA) attn_unit_latent(F, idx);
    if constexpr (RP(8)) for (int idx = w2; idx < 512; idx += NA) attn_unit_latent(F, idx);
    { const int nshort = 3 * NA - 512, j = w2 - (NA - nshort);
      if (nshort > 0 && j >= 0) { for (int it = j; it < 128; it += nshort) lru_scan_unit(F, it); for (int it = j; it < 64; it += nshort) attn_unit_ctx(F, it); }
      else if (nshort <= 0) { for (int it = w2; it < 128; it += NA) lru_scan_unit(F, it); for (int it = w2; it < 64; it += NA) attn_unit_ctx(F, it); } }
}

__device__ __forceinline__ void phase_post(Frame& F, int l, int lat_only) {
    refresh(F);
    const int gw = F.vcu * NWAVES + F.wave, NGW = F.G * NWAVES, lane = F.lane;
    f32x4 gn0 = *(const f32x4*)(F.ka->in[I_GNG] + l * 512 + 8 * lane), gn1 = *(const f32x4*)(F.ka->in[I_GNG] + l * 512 + 8 * lane + 4);
    for (int row = gw; row < M; row += NGW) {
        if (lat_only && (row % TT) >= TL) continue;
#pragma unroll
        for (int hd = 0; hd < 4; ++hd) { const int col = hd * 512 + 8 * lane;
            const u32x4 a = *(const u32x4*)(((bf16*)(F.ws + WS_OF)) + (size_t)row * D + col), bb = *(const u32x4*)(((bf16*)(F.ws + WS_OB)) + (size_t)row * D + col), rr = *(const u32x4*)(((bf16*)(F.ws + WS_PROJ)) + (size_t)row * NP + C_GR + col);
            float o[8] = {bflo(a.x) + bflo(bb.x), bfhi(a.x) + bfhi(bb.x), bflo(a.y) + bflo(bb.y), bfhi(a.y) + bfhi(bb.y), bflo(a.z) + bflo(bb.z), bfhi(a.z) + bfhi(bb.z), bflo(a.w) + bflo(bb.w), bfhi(a.w) + bfhi(bb.w)};
            const float r[8] = {bflo(rr.x), bfhi(rr.x), bflo(rr.y), bfhi(rr.y), bflo(rr.z), bfhi(rr.z), bflo(rr.w), bfhi(rr.w)};
            float ss = 0.f;
#pragma unroll
            for (int e = 0; e < 8; ++e) ss += o[e] * o[e];
            const float rstd = 1.0f / sqrtf(wave_sum(ss) * (1.0f / 512.0f) + EPS);
            const float gn[8] = {gn0.x, gn0.y, gn0.z, gn0.w, gn1.x, gn1.y, gn1.z, gn1.w};
#pragma unroll
            for (int e = 0; e < 8; ++e) o[e] = o[e] * rstd * gn[e] * siluf_(r[e]);
            u32x4 w; w.x = pk2(o[0], o[1]); w.y = pk2(o[2], o[3]); w.z = pk2(o[4], o[5]); w.w = pk2(o[6], o[7]);
            *(u32x4*)(((bf16*)(F.ws + WS_OBR)) + (size_t)row * KP + col) = w; }
#pragma unroll
        for (int j = 0; j < 4; ++j) { const int col = j * 512 + 8 * lane;
            const u32x4 a = *(const u32x4*)(((bf16*)(F.ws + WS_HS)) + (size_t)row * D + col), bb = *(const u32x4*)(((bf16*)(F.ws + WS_HS)) + ((size_t)M + row) * D + col), yy = *(const u32x4*)(((bf16*)(F.ws + WS_PROJ)) + (size_t)row * NP + C_LY + col);
            float o[8] = {bflo(a.x) + bflo(bb.x), bfhi(a.x) + bfhi(bb.x), bflo(a.y) + bflo(bb.y), bfhi(a.y) + bfhi(bb.y), bflo(a.z) + bflo(bb.z), bfhi(a.z) + bfhi(bb.z), bflo(a.w) + bflo(bb.w), bfhi(a.w) + bfhi(bb.w)};
            const float y[8] = {bflo(yy.x), bfhi(yy.x), bflo(yy.y), bfhi(yy.y), bflo(yy.z), bfhi(yy.z), bflo(yy.w), bfhi(yy.w)};
#pragma unroll
            for (int e = 0; e < 8; ++e) o[e] *= gelu_tanh(y[e]);
            u32x4 w; w.x = pk2(o[0], o[1]); w.y = pk2(o[2], o[3]); w.z = pk2(o[4], o[5]); w.w = pk2(o[6], o[7]);
            *(u32x4*)(((bf16*)(F.ws + WS_OBR)) + ((size_t)2 * M + row) * KP + col) = w; }
    }
}
}

using namespace mk;
constexpr int N_PHASES = 42;
typedef KArgs Args;

__global__ void __launch_bounds__(NTHR, 2) hybrid_fwd(Args args) {
    extern __shared__ __attribute__((aligned(16))) unsigned char lds_raw[];
    Frame F;
    F.lds = (LAS unsigned char*)lds_raw;
    F.tid = threadIdx.x; F.lane = F.tid & 63; F.wave = __builtin_amdgcn_readfirstlane(F.tid >> 6);
    F.G = gridDim.x; { const int bx = blockIdx.x; F.vcu = (F.G % 8 == 0) ? (bx % 8) * (F.G / 8) + bx / 8 : bx; }
    F.ka = &args; F.ws = args.ws;
    unsigned char* ws = args.ws;
    volatile LAS unsigned* MISC = (volatile LAS unsigned*)(F.lds + MISC_OFF);
    if (F.tid < 64) MISC[F.tid] = 0u;
    __syncthreads();
    const int lo = args.ph_lo, hi = args.ph_hi;
    XcdBarrier bar; bar.bar = (unsigned*)(ws + WS_CTL) + CW_BAR; bar.x = 0; bar.st = nullptr;
    if (hi - lo > 1) bar = xcd_barrier_post((unsigned*)(ws + WS_CTL) + CW_BAR, MISC + 8);
#define IN(k) (lo <= (k) && (k) < hi)
#define SEAM(k) do { if (hi > (k) + 1) xcd_barrier(bar); } while (0)
    const int c_id = (int)blockIdx.x;

    if (IN(0)) { if constexpr (EN(0)) phase_prologue(F); if constexpr (RP(0)) { __syncthreads(); phase_prologue(F); } SEAM(0); }
    for (int l = 0; l < DEPTH; ++l) {
        const int pb = 1 + 10 * l;
        const int lastl = (l == DEPTH - 1) ? 1 : 0;
        const float* modl = ((float*)(F.ws + WS_MOD)) + (size_t)l * 5 * (6 * D);
        if (IN(pb + 0)) { if constexpr (EN(1)) phase_norm(F, l, F.ka->in[I_NMIX] + (size_t)l * D, 0, 1, l > 0 ? 2 : 0, 0); if constexpr (RP(1)) phase_norm(F, l, F.ka->in[I_NMIX] + (size_t)l * D, 0, 1, 0, 0); SEAM(pb + 0); }
        if (IN(pb + 1)) {
            pg8::Gemm g{((bf16*)(F.ws + WS_U)), (const bf16*)(ws + WS_WIN + l * WIN_L), M, NINP, D, KP}; pg8::StaticOrder S; S.init(M, NINP, F.G, c_id, 32);
            pg8::EpiProj E{((bf16*)(F.ws + WS_PROJ)), ((float*)(F.ws + WS_DEC))};
            if constexpr (EN(2)) pg8::gemm_phase<pg8::EpiProj, pg8::StaticOrder, true, true>(F.lds, g, S, E);
            if constexpr (RP(2)) pg8::gemm_phase<pg8::EpiProj, pg8::StaticOrder, true, true>(F.lds, g, S, E);
            SEAM(pb + 1); }
        if (IN(pb + 2)) { if constexpr (EN(3)) prep_attn(F, l); if constexpr (EN(4)) prep_gla(F, l); if constexpr (RP(4)) { __syncthreads(); prep_gla(F, l); } __syncthreads(); if constexpr (EN(5)) prep_lru(F, l); if constexpr (RP(5)) { __syncthreads(); prep_lru(F, l); } SEAM(pb + 2); }
        if (IN(pb + 3)) { phase_mix(F); if constexpr (RP(6)) { __syncthreads(); phase_mix(F); } SEAM(pb + 3); }
        if (IN(pb + 4)) { if constexpr (EN(9)) phase_post(F, l, lastl); if constexpr (RP(9)) phase_post(F, l, lastl); SEAM(pb + 4); }
        if (IN(pb + 5)) {
            pg8::Gemm g{((bf16*)(F.ws + WS_OBR)), (const bf16*)(ws + WS_WBR + l * WBR_L), 3 * M, 3 * D, D, KP}; pg8::BranchOrder S; S.init(F.G, c_id, lastl);
            pg8::EpiBranch E{((bf16*)(F.ws + WS_PROJ)), F.ka->in[I_BMERGE] + (size_t)l * 3 * D, ((bf16*)(F.ws + WS_MG))};
            if constexpr (EN(10)) pg8::gemm_phase<pg8::EpiBranch, pg8::BranchOrder, true, true>(F.lds, g, S, E);
            if constexpr (RP(10)) pg8::gemm_phase<pg8::EpiBranch, pg8::BranchOrder, true, true>(F.lds, g, S, E);
            SEAM(pb + 5); }
        if (IN(pb + 6)) {
            pg8::Gemm g{((bf16*)(F.ws + WS_MG)), (const bf16*)(ws + WS_WOUT + l * WOUT_L), M, D, D, KP}; pg8::ResOrder S; S.init(F.G, F.vcu, 32, lastl);
            pg8::EpiRes E{((bf16*)(F.ws + WS_Y)), modl + 2 * D, ((float*)(F.ws + WS_SLAB))};
            if constexpr (EN(11)) pg8::gemm_phase<pg8::EpiRes, pg8::ResOrder, true, true>(F.lds, g, S, E);
            if constexpr (RP(11)) pg8::gemm_phase<pg8::EpiRes, pg8::ResOrder, true, true>(F.lds, g, S, E);
            SEAM(pb + 6); }
        if (IN(pb + 7)) { phase_norm(F, l, F.ka->in[I_NFFN] + (size_t)l * D, 3, 4, 2, lastl); SEAM(pb + 7); }
        if (IN(pb + 8)) {
            pg8::Gemm g{((bf16*)(F.ws + WS_U)), (const bf16*)(ws + WS_WF1 + l * WF1_L), M, NF1, D, KP}; pg8::StaticOrder S; S.init(lastl ? 8192 : M, NF1, F.G, c_id, 32, lastl);
            pg8::EpiSwiglu E{((bf16*)(F.ws + WS_ACT))};
            if constexpr (EN(12)) pg8::gemm_phase<pg8::EpiSwiglu, pg8::StaticOrder, true, true>(F.lds, g, S, E);
            if constexpr (RP(12)) pg8::gemm_phase<pg8::EpiSwiglu, pg8::StaticOrder, true, true>(F.lds, g, S, E);
            SEAM(pb + 8); }
        if (IN(pb + 9)) {
            pg8::Gemm g{((bf16*)(F.ws + WS_ACT)), (const bf16*)(ws + WS_WF2 + l * WF2_L), M, D, FF, FF}; pg8::ResOrder S; S.init(F.G, F.vcu, 88, lastl);
            pg8::EpiRes E{((bf16*)(F.ws + WS_Y)), modl + 5 * D, ((float*)(F.ws + WS_SLAB))};
            if constexpr (EN(13)) pg8::gemm_phase<pg8::EpiRes, pg8::ResOrder, true, true>(F.lds, g, S, E);
            if constexpr (RP(13)) pg8::gemm_phase<pg8::EpiRes, pg8::ResOrder, true, true>(F.lds, g, S, E);
            SEAM(pb + 9); }
    }
    if (IN(41)) { if constexpr (EN(14)) phase_final(F); }
#undef IN
#undef SEAM
}

#ifndef MK_LAUNCH_PER_PHASE
#define MK_LAUNCH_PER_PHASE 0
#endif
extern "C" void kernel_launch(void* const* d_in, const int* in_sizes, int n_in, void* d_out, int out_size, void* d_ws, size_t ws_size, hipStream_t stream) {
    static int grid = 0;
    if (grid == 0) {
        if (n_in != N_INPUTS || out_size != NB * TL * D || ws_size < WS_END) { fprintf(stderr, "kernel_launch: shape mismatch n_in %d out %d ws %zu (need %zu)\n", n_in, out_size, ws_size, (size_t)WS_END); grid = -1; return; }
        int dev = 0, cus = 0, per_cu = 0;
        if (hipGetDevice(&dev) != hipSuccess || hipDeviceGetAttribute(&cus, hipDeviceAttributeMultiprocessorCount, dev) != hipSuccess) { grid = -1; return; }
        if (hipFuncSetAttribute((const void*)hybrid_fwd, hipFuncAttributeMaxDynamicSharedMemorySize, LDS_BYTES) != hipSuccess) { fprintf(stderr, "kernel_launch: hipFuncSetAttribute failed\n"); grid = -1; return; }
        if (hipOccupancyMaxActiveBlocksPerMultiprocessor(&per_cu, (const void*)hybrid_fwd, NTHR, LDS_BYTES) != hipSuccess || per_cu < 1) fprintf(stderr, "kernel_launch: occupancy query says %d\n", per_cu);
        (void)hipGetLastError();
        grid = cus;
        if (grid != 256) fprintf(stderr, "kernel_launch: %d CUs (built for 256)\n", grid);
    }
    if (grid < 0) return;
    (void)hipMemsetAsync((char*)d_ws + WS_CTL, 0, CTL_ZERO_BYTES, stream);
    Args a{};
    for (int i = 0; i < N_INPUTS; ++i) a.in[i] = (const float*)d_in[i];
    a.out = (float*)d_out; a.ws = (unsigned char*)d_ws;
#if MK_LAUNCH_PER_PHASE
    for (int p = 0; p < N_PHASES; ++p) { a.ph_lo = p; a.ph_hi = p + 1; hipLaunchKernelGGL(hybrid_fwd, dim3(grid), dim3(NTHR), LDS_BYTES, stream, a); }
#else
    a.ph_lo = 0; a.ph_hi = N_PHASES; hipLaunchKernelGGL(hybrid_fwd, dim3(grid), dim3(NTHR), LDS_BYTES, stream, a);
#endif
    const hipError_t le = hipPeekAtLastError();
    if (le != hipSuccess) fprintf(stderr, "kernel_launch: launch failed: %s\n", hipGetErrorName(le));
}
```
